# Optimizing an MI355X kernel written in HIP

```python
import math
import jax, jax.numpy as jnp
from jax import lax
import numpy as np

D_MODEL = 1024
BATCH = 8
SEQ = 2048
DEPTH = 4
DEC_BATCH = 128
DEC_SEQ = 4
PAST_LEN = 16384
PAGE_SIZE = 128

N_MIXERS = 2
N_RET = (DEPTH + 1) // 2
N_HGRN = DEPTH // 2
RET_HEADS = 4
RET_DK = D_MODEL // RET_HEADS
RET_DV = 2 * RET_DK
RET_QK = RET_HEADS * RET_DK
RET_V = RET_HEADS * RET_DV
RET_CHUNK = 128
ROPE_BASE = 10000.0
HG_EXPAND = 128
HG_HEADS = D_MODEL // HG_EXPAND
HG_DK = HG_EXPAND
HG_DV = D_MODEL // HG_HEADS
HG_CHUNK = 16
D_FF = 2816
EPS = 1e-6

kernel_name = "retnet_hgrn2_macaron_hybrid_step"


def rmsnorm(x, gain):
    xf = x.astype(jnp.float32)
    y = xf * lax.rsqrt(jnp.mean(xf * xf, axis=-1, keepdims=True) + EPS)
    return (y * gain.astype(jnp.float32)).astype(x.dtype)


def head_rmsnorm(o, gain):
    y = o * lax.rsqrt(jnp.mean(o * o, axis=-1, keepdims=True) + EPS)
    return y * gain.astype(jnp.float32)[None, :, None, :]


def swiglu_ffn(x, w_up, w_down):
    a, b = jnp.split(x @ w_up, 2, axis=-1)
    return (jax.nn.silu(a) * b) @ w_down


def split_heads(a, n_heads):
    B, T, _ = a.shape
    return a.reshape(B, T, n_heads, -1).transpose(0, 2, 1, 3).astype(jnp.float32)


def merge_heads(o):
    B, H, T, d = o.shape
    return o.transpose(0, 2, 1, 3).reshape(B, T, H * d)


def rotary(x, pos):
    half = x.shape[-1] // 2
    inv_freq = ROPE_BASE ** (-jnp.arange(half, dtype=jnp.float32) / half)
    ang = pos[:, None] * inv_freq[None, :]
    cos, sin = jnp.cos(ang), jnp.sin(ang)
    x1, x2 = x[..., :half], x[..., half:]
    return jnp.concatenate([x1 * cos - x2 * sin, x1 * sin + x2 * cos], axis=-1)


def to_chunks(a, C):
    B, H, T, d = a.shape
    return jnp.moveaxis(a.reshape(B, H, T // C, C, d), 2, 0)


def from_chunks(a):
    n, B, H, C, d = a.shape
    return jnp.moveaxis(a, 0, 2).reshape(B, H, n * C, d)


def retention_chunkwise(q, k, v, S0, log_gamma):
    T = q.shape[2]
    C = math.gcd(T, RET_CHUNK)
    idx = jnp.arange(C, dtype=jnp.float32)
    diff = idx[:, None] - idx[None, :]
    lg = log_gamma[:, None, None]
    decay_mat = jnp.where(diff[None] >= 0, jnp.exp(diff[None] * lg), 0.0)
    q_decay = jnp.exp((idx[None, :] + 1.0) * log_gamma[:, None])
    k_decay = jnp.exp((C - 1.0 - idx[None, :]) * log_gamma[:, None])
    chunk_decay = jnp.exp(C * log_gamma)

    def step(S, inp):
        qc, kc, vc = inp
        scores = jnp.einsum('bhtd,bhsd->bhts', qc, kc) * decay_mat[None]
        o = (jnp.einsum('bhts,bhse->bhte', scores, vc)
             + jnp.einsum('bhtd,bhde->bhte', qc, S) * q_decay[None, :, :, None])
        S = (S * chunk_decay[None, :, None, None]
             + jnp.einsum('bhsd,bhse->bhde', kc * k_decay[None, :, :, None], vc))
        return S, o

    S, o = lax.scan(step, S0, (to_chunks(q, C), to_chunks(k, C), to_chunks(v, C)))
    return from_chunks(o), S


def hgrn2_chunkwise(q, k, v, g, S0):
    T = q.shape[2]
    C = math.gcd(T, HG_CHUNK)
    causal = jnp.tril(jnp.ones((C, C), dtype=bool))

    def step(S, inp):
        qc, kc, vc, gc = inp
        b = jnp.cumsum(gc, axis=2)
        rel = jnp.where(causal[None, None, :, :, None],
                        b[:, :, :, None, :] - b[:, :, None, :, :], -jnp.inf)
        scores = jnp.einsum('bhtd,bhsd,bhtsd->bhts', qc, kc, jnp.exp(rel))
        o = (jnp.einsum('bhts,bhse->bhte', scores, vc)
             + jnp.einsum('bhtd,bhde->bhte', qc * jnp.exp(b), S))
        b_last = b[:, :, -1:, :]
        S = (jnp.exp(b_last)[:, :, 0, :, None] * S
             + jnp.einsum('bhsd,bhse->bhde', kc * jnp.exp(b_last - b), vc))
        return S, o

    S, o = lax.scan(step, S0, (to_chunks(q, C), to_chunks(k, C), to_chunks(v, C), to_chunks(g, C)))
    return from_chunks(o), S


def retention_mixer(x, pos, S0, w_in, gn, w_out):
    h = x @ w_in
    q, k, v, gate = jnp.split(h, [RET_QK, 2 * RET_QK, 2 * RET_QK + RET_V], axis=-1)
    q = rotary(split_heads(q, RET_HEADS), pos)
    k = rotary(split_heads(k, RET_HEADS), pos) * (RET_DK ** -0.5)
    v = split_heads(v, RET_HEADS)
    log_gamma = jnp.log(1.0 - jnp.power(2.0, -5.0 - jnp.arange(RET_HEADS, dtype=jnp.float32)))
    o, S = retention_chunkwise(q, k, v, S0.astype(jnp.float32), log_gamma)
    o = merge_heads(head_rmsnorm(o, gn)).astype(x.dtype)
    return (jax.nn.silu(gate) * o) @ w_out, S


def hgrn2_mixer(x, S0, lb, w_in, gn, w_out):
    h = x @ w_in
    q, z, i, gate = jnp.split(h, 4, axis=-1)
    q = jax.nn.silu(split_heads(q, HG_HEADS))
    z = split_heads(z, HG_HEADS)
    v = split_heads(i, HG_HEADS)
    lbh = lb.astype(jnp.float32).reshape(HG_HEADS, HG_DK)[None, :, None, :]
    g = jnp.logaddexp(jnp.log(lbh), jnp.log1p(-lbh) + jax.nn.log_sigmoid(z))
    k = (1.0 - lbh) * jax.nn.sigmoid(-z)
    o, S = hgrn2_chunkwise(q, k, v, g, S0.astype(jnp.float32))
    o = merge_heads(head_rmsnorm(o, gn)).astype(x.dtype)
    return (jax.nn.silu(gate) * o) @ w_out, S


def trunk(x, pos, ret_state, hg_state, norm_gain, ffn_w_up, ffn_w_down,
          ret_w_in, ret_norm, ret_w_out, hg_w_in, hg_lb_logits, hg_norm, hg_w_out, final_norm):
    lb_all = jnp.cumsum(jax.nn.softmax(hg_lb_logits.astype(jnp.float32), axis=0), axis=0)
    lb_all = lb_all - lb_all[:1]
    new_ret, new_hg = [], []
    for layer in range(DEPTH):
        x = x + 0.5 * swiglu_ffn(rmsnorm(x, norm_gain[layer, 0]), ffn_w_up[layer, 0], ffn_w_down[layer, 0])
        h = rmsnorm(x, norm_gain[layer, 1])
        j = layer // N_MIXERS
        if layer % N_MIXERS == 0:
            y, S = retention_mixer(h, pos, ret_state[j], ret_w_in[j], ret_norm[j], ret_w_out[j])
            new_ret.append(S.astype(ret_state.dtype))
        else:
            y, S = hgrn2_mixer(h, hg_state[j], lb_all[j], hg_w_in[j], hg_norm[j], hg_w_out[j])
            new_hg.append(S.astype(hg_state.dtype))
        x = x + y
        x = x + 0.5 * swiglu_ffn(rmsnorm(x, norm_gain[layer, 2]), ffn_w_up[layer, 1], ffn_w_down[layer, 1])
    return rmsnorm(x, final_norm), jnp.stack(new_ret), jnp.stack(new_hg)


def setup_inputs(seed: int = 0) -> dict:
    key = jax.random.key(seed)
    ks = jax.random.split(key, 16)
    f32 = jnp.float32
    nrm = lambda k, shape, s: jax.random.normal(k, shape, f32) * s
    return {
        "x_prompt": nrm(ks[0], (BATCH, SEQ, D_MODEL), 1.0),
        "x_sample": nrm(ks[1], (DEC_BATCH, DEC_SEQ, D_MODEL), 1.0),
        "state_ret": nrm(ks[2], (N_RET, DEC_BATCH, RET_HEADS, RET_DK, RET_DV), 0.05),
        "state_hgrn": nrm(ks[3], (N_HGRN, DEC_BATCH, HG_HEADS, HG_DK, HG_DV), 0.5),
        "norm_gain": 1.0 + nrm(ks[4], (DEPTH, 3, D_MODEL), 0.02),
        "ffn_w_up": nrm(ks[5], (DEPTH, 2, D_MODEL, 2 * D_FF), D_MODEL ** -0.5),
        "ffn_w_down": nrm(ks[6], (DEPTH, 2, D_FF, D_MODEL), D_FF ** -0.5),
        "ret_w_in": nrm(ks[7], (N_RET, D_MODEL, 2 * RET_QK + 2 * RET_V), D_MODEL ** -0.5),
        "ret_norm": 1.0 + nrm(ks[8], (N_RET, RET_HEADS, RET_DV), 0.02),
        "ret_w_out": nrm(ks[9], (N_RET, RET_V, D_MODEL), RET_V ** -0.5),
        "hg_w_in": nrm(ks[10], (N_HGRN, D_MODEL, 4 * D_MODEL), D_MODEL ** -0.5),
        "hg_lb_logits": nrm(ks[11], (N_HGRN, HG_HEADS * HG_DK), 0.1),
        "hg_norm": 1.0 + nrm(ks[12], (N_HGRN, HG_HEADS, HG_DV), 0.02),
        "hg_w_out": nrm(ks[13], (N_HGRN, D_MODEL, D_MODEL), D_MODEL ** -0.5),
        "final_norm": 1.0 + nrm(ks[14], (D_MODEL,), 0.02),
    }


def reference(x_prompt, x_sample, state_ret, state_hgrn, norm_gain, ffn_w_up, ffn_w_down,
              ret_w_in, ret_norm, ret_w_out, hg_w_in, hg_lb_logits, hg_norm, hg_w_out, final_norm):
    pos_prompt = jnp.arange(SEQ, dtype=jnp.float32)
    pos_sample = PAST_LEN + jnp.arange(DEC_SEQ, dtype=jnp.float32)
    ret0 = jnp.zeros((N_RET, BATCH, RET_HEADS, RET_DK, RET_DV), state_ret.dtype)
    hg0 = jnp.zeros((N_HGRN, BATCH, HG_HEADS, HG_DK, HG_DV), state_hgrn.dtype)
    y_prompt, ret_prompt, hg_prompt = trunk(
        x_prompt, pos_prompt, ret0, hg0, norm_gain, ffn_w_up, ffn_w_down,
        ret_w_in, ret_norm, ret_w_out, hg_w_in, hg_lb_logits, hg_norm, hg_w_out, final_norm)
    y_sample, ret_sample, hg_sample = trunk(
        x_sample, pos_sample, state_ret, state_hgrn, norm_gain, ffn_w_up, ffn_w_down,
        ret_w_in, ret_norm, ret_w_out, hg_w_in, hg_lb_logits, hg_norm, hg_w_out, final_norm)
    return (y_prompt, y_sample, ret_prompt, ret_sample, hg_prompt, hg_sample)
```

```cpp
#include <hip/hip_runtime.h>
#include <cstdio>
#include <cstdint>
namespace pg8 {
#define PG8_LAS __attribute__((address_space(3)))
typedef unsigned short bf16_t;
typedef short bf16x8 __attribute__((ext_vector_type(8)));
typedef float f32x4 __attribute__((ext_vector_type(4)));
typedef unsigned u32x4 __attribute__((ext_vector_type(4)));
constexpr int BM = 256, BK = 64, HALF = 128, HTB = HALF * BK * 2  , STAGE_BYTES = 8 * HTB, NXCD = 8, WGM = 8;

__host__ __device__ __forceinline__ int lds_byte(int r, int c) { const int st = (r >> 4) * 2 + (c >> 5), rr = r & 15, cc = c & 31, ob = rr * 64 + cc * 2; return st * 1024 + (ob ^ (((ob >> 9) & 1) << 5)); }
__host__ __device__ __forceinline__ void stage_rc(int b, int& R, int& C) { const int st = b / 1024, sb = b % 1024, swz = sb ^ (((sb >> 9) & 1) << 5); R = (st >> 1) * 16 + swz / 64; C = (st & 1) * 32 + (swz % 64) / 2; }
__host__ __device__ __forceinline__ int perm32(int rho) { const int n = rho >> 4, i = rho & 15; return 8 * (i >> 2) + 4 * n + (i & 3); }

struct Unit { int pm, pn; };
struct Gemm { const bf16_t* A; const bf16_t* Bt; int M, N, K; };

struct StaticOrder {
    int nM, nN, nwg, G, c;
    __host__ __device__ void init(int M, int N, int G_, int c_) { nM = M / BM; nN = N / BM; nwg = nM * nN; G = G_; c = c_; }
    __host__ __device__ bool next(int i, Unit& u) const {
        const long L = (long)i * G + c; if (L >= nwg) return false;
        int wgid = (int)L; { const int q = nwg / NXCD, r = nwg % NXCD, xcd = wgid % NXCD, off = wgid / NXCD; wgid = (xcd < r ? xcd * (q + 1) : r * (q + 1) + (xcd - r) * q) + off; }
        const int nig = WGM * nN, gid = wgid / nig, fm = gid * WGM, gsz = (nM - fm) < WGM ? (nM - fm) : WGM;
        u.pm = fm + ((wgid % nig) % gsz); u.pn = (wgid % nig) / gsz; return true;
    }
    __device__ __forceinline__ void a_ready(const Unit&) const {}
    __device__ __forceinline__ void done(const Unit&) const {}
};

__device__ __forceinline__ unsigned cvt_pk_bf16(float lo, float hi) { unsigned r; asm volatile("v_cvt_pk_bf16_f32 %0, %1, %2" : "=v"(r) : "v"(lo), "v"(hi)); return r; }
template <class Epi, class Sched, bool ALIGN_EPI = false, bool SP2 = false>
__device__ __forceinline__ void gemm_phase(PG8_LAS unsigned char* lds, const Gemm g, const Sched& S, const Epi& E) {
    int tid_ = threadIdx.x; asm volatile("" : "+v"(tid_));
    const int tid = tid_, wid = __builtin_amdgcn_readfirstlane(tid >> 6), lane = tid & 63, wr = wid >> 2, wc = wid & 3, fr = lane & 15, fq = lane >> 4;
    const int K = g.K, nt = K / BK;
    unsigned voffA[2], voffB[2];
#pragma unroll
    for (int i = 0; i < 2; ++i) { int R, C; stage_rc(tid * 16 + i * 8192, R, C); const int Rb = Epi::PERM ? ((R & ~31) + perm32(R & 31)) : R;
        voffA[i] = (unsigned)(R * K + C) * 2u; voffB[i] = (unsigned)(Rb * K + C) * 2u; }
    const size_t kstep = (size_t)(BK * 2);
    const size_t hstep = (size_t)HALF * K * 2;
    const size_t tstep = 2 * hstep;
    const unsigned ldsw = (unsigned)wid * 1024u;
    const int aoff = lds_byte(wr * 64 + fr, fq * 8), boff = lds_byte(wc * 32 + fr, fq * 8);
#define PG8_SA(b, h) (((b) * 2 + (h)) * HTB)
#define PG8_SB(b, h) ((4 + (b) * 2 + (h)) * HTB)
#define PG8_STAGE(bufoff, gbase, voff) do { _Pragma("unroll") for (int _i = 0; _i < 2; ++_i) \
        __builtin_amdgcn_global_load_lds((const unsigned*)((const char*)(gbase) + (voff)[_i]), (PG8_LAS unsigned*)(lds + (bufoff) + ldsw + _i * 8192), 16, 0, 0); } while (0)
#define PG8_LDA(dst, b, h) do { _Pragma("unroll") for (int m = 0; m < 4; ++m) _Pragma("unroll") for (int k = 0; k < 2; ++k) dst[m][k] = *(const PG8_LAS bf16x8*)(lds + PG8_SA(b, h) + aoff + m * 2048 + k * 1024); } while (0)
#define PG8_LDB(dst, b, h) do { _Pragma("unroll") for (int n = 0; n < 2; ++n) _Pragma("unroll") for (int k = 0; k < 2; ++k) dst[n][k] = *(const PG8_LAS bf16x8*)(lds + PG8_SB(b, h) + boff + n * 2048 + k * 1024); } while (0)
#define PG8_MMA(ai, bj, At, Bt) do { __builtin_amdgcn_s_setprio(1); _Pragma("unroll") for (int m = 0; m < 4; ++m) _Pragma("unroll") for (int n = 0; n < 2; ++n) _Pragma("unroll") for (int k = 0; k < 2; ++k) \
        acc[ai][bj][m][n] = __builtin_amdgcn_mfma_f32_16x16x32_bf16(Bt[n][k], At[m][k], acc[ai][bj][m][n], 0, 0, 0); __builtin_amdgcn_s_setprio(0); } while (0)
#define PG8_WAIT_V(n) asm volatile("s_waitcnt vmcnt(" #n ")" ::: "memory")
#define PG8_WAIT_L(n) asm volatile("s_waitcnt lgkmcnt(" #n ")" ::: "memory")
#define PG8_BAR __builtin_amdgcn_s_barrier()
#define PG8_SCHED __builtin_amdgcn_sched_barrier(0)
    Unit cur, nxt; int ui = 0;
    if (!S.next(0, cur)) return;
    f32x4 acc[2][2][4][2];
#pragma unroll
    for (int a = 0; a < 2; ++a)
#pragma unroll
        for (int b = 0; b < 2; ++b)
#pragma unroll
            for (int m = 0; m < 4; ++m)
#pragma unroll
                for (int n = 0; n < 2; ++n) acc[a][b][m][n] = (f32x4){0.f, 0.f, 0.f, 0.f};
    bf16x8 At[4][2], B0[2][2], B1[2][2];
    const char* cA = (const char*)g.A + (size_t)cur.pm * tstep; const char* cB = (const char*)g.Bt + (size_t)cur.pn * tstep;
    S.a_ready(cur);
    if constexpr (SP2) {
        PG8_STAGE(PG8_SB(0, 0), cB, voffB); PG8_STAGE(PG8_SB(0, 1), cB + hstep, voffB); PG8_STAGE(PG8_SA(0, 0), cA, voffA); PG8_STAGE(PG8_SA(0, 1), cA + hstep, voffA);
        if (wr == 1) PG8_BAR;
        PG8_WAIT_V(2); PG8_BAR;
        PG8_STAGE(PG8_SB(1, 0), cB + kstep, voffB); PG8_STAGE(PG8_SA(1, 0), cA + kstep, voffA); PG8_STAGE(PG8_SB(1, 1), cB + hstep + kstep, voffB);
        PG8_WAIT_V(6); PG8_BAR;
    } else {
        PG8_STAGE(PG8_SB(0, 0), cB, voffB); PG8_STAGE(PG8_SA(0, 0), cA, voffA); PG8_STAGE(PG8_SB(0, 1), cB + hstep, voffB); PG8_STAGE(PG8_SA(0, 1), cA + hstep, voffA);
        if (wr == 1) PG8_BAR;
        PG8_WAIT_V(4); PG8_BAR;
        PG8_STAGE(PG8_SB(1, 0), cB + kstep, voffB); PG8_STAGE(PG8_SA(1, 0), cA + kstep, voffA); PG8_STAGE(PG8_SB(1, 1), cB + hstep + kstep, voffB);
        PG8_WAIT_V(6); PG8_BAR;
    }
    for (;;) {
        const bool has_next = S.next(ui + 1, nxt);
        const char* nA = has_next ? (const char*)g.A + (size_t)nxt.pm * tstep : cA; const char* nB = has_next ? (const char*)g.Bt + (size_t)nxt.pn * tstep : cB;
        for (int t = 0; t < nt; t += 2) {
            const bool last = (t == nt - 2);
            const char* a1 = cA + (size_t)(t + 1) * kstep;
            const char* a2 = last ? nA : cA + (size_t)(t + 2) * kstep; const char* b2 = last ? nB : cB + (size_t)(t + 2) * kstep;
            const char* a3 = a2 + kstep; const char* b3 = b2 + kstep;
            if (last && has_next) S.a_ready(nxt);
            if constexpr (SP2) {
            PG8_LDB(B0, 0, 0); PG8_LDB(B1, 0, 1); PG8_SCHED; PG8_LDA(At, 0, 0); PG8_STAGE(PG8_SA(1, 1), a1 + hstep, voffA);
            PG8_WAIT_V(8); PG8_WAIT_L(0); PG8_BAR; PG8_MMA(0, 0, At, B0); PG8_MMA(0, 1, At, B1); PG8_BAR; PG8_SCHED;
            PG8_LDA(At, 0, 1); PG8_STAGE(PG8_SB(0, 0), b2, voffB); PG8_STAGE(PG8_SB(0, 1), b2 + hstep, voffB); PG8_STAGE(PG8_SA(0, 0), a2, voffA);
            PG8_WAIT_V(8); PG8_WAIT_L(0); PG8_BAR; PG8_MMA(1, 0, At, B0); PG8_MMA(1, 1, At, B1); PG8_BAR; PG8_SCHED;
            PG8_LDB(B0, 1, 0); PG8_LDB(B1, 1, 1); PG8_SCHED; PG8_LDA(At, 1, 0); PG8_STAGE(PG8_SA(0, 1), a2 + hstep, voffA);
            PG8_WAIT_V(8); PG8_WAIT_L(0); PG8_BAR; PG8_MMA(0, 0, At, B0); PG8_MMA(0, 1, At, B1); PG8_BAR; PG8_SCHED;
            PG8_LDA(At, 1, 1); PG8_STAGE(PG8_SB(1, 0), b3, voffB); PG8_STAGE(PG8_SB(1, 1), b3 + hstep, voffB); PG8_STAGE(PG8_SA(1, 0), a3, voffA);
            PG8_WAIT_V(8); PG8_WAIT_L(0); PG8_BAR; PG8_MMA(1, 0, At, B0); PG8_MMA(1, 1, At, B1); PG8_BAR; PG8_SCHED;
            } else {
            PG8_LDB(B0, 0, 0); PG8_SCHED; PG8_LDA(At, 0, 0); PG8_STAGE(PG8_SA(1, 1), a1 + hstep, voffA);
            PG8_WAIT_L(8); PG8_BAR; PG8_WAIT_L(0); PG8_MMA(0, 0, At, B0); PG8_BAR; PG8_SCHED;
            PG8_LDB(B1, 0, 1); PG8_STAGE(PG8_SB(0, 0), b2, voffB);
            PG8_BAR; PG8_WAIT_L(0); PG8_MMA(0, 1, At, B1); PG8_BAR;
            PG8_LDA(At, 0, 1); PG8_STAGE(PG8_SA(0, 0), a2, voffA);
            PG8_BAR; PG8_WAIT_L(0); PG8_MMA(1, 0, At, B0); PG8_BAR; PG8_SCHED;
            PG8_STAGE(PG8_SB(0, 1), b2 + hstep, voffB);
            PG8_WAIT_V(6); PG8_BAR; PG8_MMA(1, 1, At, B1); PG8_BAR;
            PG8_LDB(B0, 1, 0); PG8_SCHED; PG8_LDA(At, 1, 0); PG8_STAGE(PG8_SA(0, 1), a2 + hstep, voffA);
            PG8_WAIT_L(8); PG8_BAR; PG8_WAIT_L(0); PG8_MMA(0, 0, At, B0); PG8_BAR; PG8_SCHED;
            PG8_LDB(B1, 1, 1); PG8_STAGE(PG8_SB(1, 0), b3, voffB);
            PG8_BAR; PG8_WAIT_L(0); PG8_MMA(0, 1, At, B1); PG8_BAR;
            PG8_LDA(At, 1, 1); PG8_STAGE(PG8_SA(1, 0), a3, voffA);
            PG8_BAR; PG8_WAIT_L(0); PG8_MMA(1, 0, At, B0); PG8_BAR; PG8_SCHED;
            PG8_STAGE(PG8_SB(1, 1), b3 + hstep, voffB);
            PG8_WAIT_V(6); PG8_BAR; PG8_MMA(1, 1, At, B1); PG8_BAR;
            }
        }
        if constexpr (ALIGN_EPI) { if (wr == 0) PG8_BAR; }
        if constexpr (!Epi::AFTER_DRAIN) { E(acc, cur, wr, wc, fr, fq); S.done(cur); }
        if (!has_next) break;
#pragma unroll
        for (int a = 0; a < 2; ++a)
#pragma unroll
            for (int b = 0; b < 2; ++b)
#pragma unroll
                for (int m = 0; m < 4; ++m)
#pragma unroll
                    for (int n = 0; n < 2; ++n) acc[a][b][m][n] = (f32x4){0.f, 0.f, 0.f, 0.f};
        cur = nxt; cA = nA; cB = nB; ++ui;
        if constexpr (ALIGN_EPI) { if (wr == 1) PG8_BAR; }
    }
    PG8_WAIT_V(0);
    if constexpr (!ALIGN_EPI) { if (wr == 0) PG8_BAR; }
    PG8_BAR;
    if constexpr (Epi::AFTER_DRAIN) { E.fused(acc, cur, wr, wc, fr, fq, lds, wid, lane); S.done(cur); }
#undef PG8_SA
#undef PG8_SB
#undef PG8_STAGE
#undef PG8_LDA
#undef PG8_LDB
#undef PG8_MMA
#undef PG8_WAIT_V
#undef PG8_WAIT_L
#undef PG8_BAR
#undef PG8_SCHED
}
}

constexpr int NWAVES = 8;
constexpr int D = 1024, FF = 2816, NUP = 2 * FF;
constexpr int MP = 8 * 2048, MS = 128 * 4, M = MP + MS;
constexpr int NSEQ_P = 8, TP = 2048, NSEQ_S = 128, TS = 4;
constexpr int R_H = 4, R_DK = 256, R_DV = 512, R_QK = 1024, R_V = 2048, R_NIN = 6144;
constexpr int G_H = 8, G_DK = 128, G_DV = 128, G_NIN = 4096;
constexpr int R_C = 128, G_C = 16;
constexpr float EPS = 1e-6f;
constexpr int NPHASE = 34;

constexpr size_t MiB = 1u << 20;
constexpr size_t WS_CTL = 0, CTL_ZERO_BYTES = 65536;
constexpr int CW_TMO = 0, CW_CODE = 1, CW_BAR = 1024;
constexpr size_t WS_ROPE = 1 * MiB;
constexpr size_t WS_TAB2 = 3 * MiB + 512 * 1024;
constexpr size_t WS_W = 4 * MiB;
constexpr size_t W_FFN_STRIDE = 16 * MiB + 512 * 1024, W_DOWN_OFF = 11 * MiB;
constexpr size_t W_RET_BASE = 132 * MiB, W_RET_STRIDE = 16 * MiB, W_ROUT_OFF = 12 * MiB;
constexpr size_t W_HG_BASE = 164 * MiB, W_HG_STRIDE = 10 * MiB, W_HOUT_OFF = 8 * MiB;
constexpr size_t WS_X = 192 * MiB, WS_XB = 258 * MiB, WS_HID = 291 * MiB, WS_QB = 382 * MiB, WS_KB = 415 * MiB, WS_VB = 448 * MiB, WS_GB = 514 * MiB,
                 WS_OF = 580 * MiB, WS_OB = 712 * MiB, WS_EB = 778 * MiB, WS_SSQ = 784 * MiB, WS_END = 800 * MiB;
constexpr int SSQ_SLOTS = 16;
static_assert(WS_SSQ + 13 * (size_t)M * SSQ_SLOTS * 4 <= WS_END, "ssq region");
static_assert(WS_X + (size_t)M * D * 4 <= WS_XB && WS_XB + (size_t)M * D * 2 <= WS_HID && WS_HID + (size_t)M * FF * 2 <= WS_QB && WS_OF + (size_t)M * R_V * 4 <= WS_OB, "ws map");

constexpr int RING_OFF = 0, RING_BYTES = 131072;
constexpr int LDSCTL_OFF = RING_BYTES, MISC_OFF = LDSCTL_OFF + 320;
constexpr int LDS_BYTES = 147456;

#define GAS __attribute__((address_space(1)))
#define LAS __attribute__((address_space(3)))
typedef unsigned short bf16;
typedef unsigned v4u __attribute__((ext_vector_type(4)));
typedef unsigned v2u __attribute__((ext_vector_type(2)));
typedef float f32x4 __attribute__((ext_vector_type(4)));
typedef GAS unsigned gu32;
#define RLX_AGENT __ATOMIC_RELAXED, __HIP_MEMORY_SCOPE_AGENT
#define LDS_WAIT() asm volatile("s_waitcnt lgkmcnt(0)" ::: "memory")
#define VM_WAIT() asm volatile("s_waitcnt vmcnt(0)" ::: "memory")
__device__ __forceinline__ unsigned f2bf(float f) { unsigned u = __builtin_bit_cast(unsigned, f); return (u + 0x7fffu + ((u >> 16) & 1u)) >> 16; }
__device__ __forceinline__ unsigned pk2(float lo, float hi) { return f2bf(lo) | (f2bf(hi) << 16); }
__device__ __forceinline__ float bf2f(unsigned short b) { return __builtin_bit_cast(float, (unsigned)b << 16); }
__device__ __forceinline__ float bflo(unsigned w) { return __builtin_bit_cast(float, w << 16); }
__device__ __forceinline__ float bfhi(unsigned w) { return __builtin_bit_cast(float, w & 0xffff0000u); }
__device__ __forceinline__ float fast_sigmoid(float x) { return __builtin_amdgcn_rcpf(1.0f + __expf(-x)); }
__device__ __forceinline__ float fast_silu(float x) { return x * fast_sigmoid(x); }
__device__ __forceinline__ float wave_sum(float v) {
#pragma unroll
    for (int o = 1; o < 64; o <<= 1) v += __shfl_xor(v, o);
    return v;
}
__device__ __forceinline__ int pos_index(int row) { return row < MP ? (row & (TP - 1)) : TP + (row & 3); }
__device__ __forceinline__ int ret_tprime(int row) { return row < MP ? (row & (R_C - 1)) : (row & 3); }

#define XB_TMO      128
#define XB_XCNT(j)  (256  + 64 * (j))
#define XB_XSUB(j)  (1280 + 64 * (j))
#define XB_XGEN(j)  (2304 + 64 * (j))
#define XB_TOP      3328
#define XB_TOPGEN   3392
#define XCD_BAR_WORDS 3456
#define XB_SPIN_CAP (1u << 18)

__device__ __forceinline__ unsigned xb_ld(unsigned* p)              { return __hip_atomic_load(p, __ATOMIC_RELAXED, __HIP_MEMORY_SCOPE_AGENT); }
__device__ __forceinline__ unsigned xb_add(unsigned* p, unsigned v) { return __hip_atomic_fetch_add(p, v, __ATOMIC_RELAXED, __HIP_MEMORY_SCOPE_AGENT); }
__device__ __forceinline__ unsigned xb_xcc_id() { return (unsigned)__builtin_amdgcn_s_getreg((3 << 11) | 20) & 0xFu; }
#define XB_SPIN(cond, bar) do { unsigned _sp = 0; while (cond) { __builtin_amdgcn_s_sleep(1); \
    if ((++_sp & 255u) == 0u) { if (xb_ld(&(bar)[XB_TMO])) break; if (_sp > XB_SPIN_CAP) { atomicAdd(&(bar)[XB_TMO], 1u); break; } } } } while (0)

struct XcdBarrier {
    unsigned* bar; unsigned x;
    volatile LAS unsigned* st;
};

__device__ __forceinline__ XcdBarrier xcd_barrier_post(unsigned* bar, volatile LAS unsigned* st) {
    XcdBarrier b; b.bar = bar; b.x = xb_xcc_id(); b.st = st;
    if (threadIdx.x == 0) (void)xb_add(&bar[XB_XCNT(b.x)], 1u);
    return b;
}
__device__ __forceinline__ void xcd_barrier_complete(unsigned* bar, unsigned x, unsigned& nloc, unsigned& nx) {
    const unsigned G = gridDim.x * gridDim.y * gridDim.z;
    unsigned sum, cnt, mine, sp = 0u;
    for (;;) {
        sum = 0u; cnt = 0u; mine = 0u;
#pragma unroll
        for (unsigned j = 0; j < 16; ++j) { const unsigned c = xb_ld(&bar[XB_XCNT(j)]); sum += c; cnt += (c > 0u) ? 1u : 0u; mine = (j == x) ? c : mine; }
        if (sum == G) break;
        __builtin_amdgcn_s_sleep(1);
        if ((++sp & 255u) == 0u) { if (xb_ld(&bar[XB_TMO])) break; if (sp > XB_SPIN_CAP) { atomicAdd(&bar[XB_TMO], 1u); break; } }
    }
    nloc = mine > 0u ? mine : 1u; nx = cnt > 0u ? cnt : 1u;
}

__device__ __forceinline__ void xcd_barrier(const XcdBarrier& b) {
    asm volatile("s_waitcnt vmcnt(0)" ::: "memory");
    __syncthreads();
    if (threadIdx.x == 0) {
        unsigned* bar = b.bar;
        __builtin_amdgcn_s_waitcnt(0);
        unsigned nloc = b.st[0], nx = b.st[1];
        if (nloc == 0u) { xcd_barrier_complete(bar, b.x, nloc, nx); b.st[0] = nloc; b.st[1] = nx; }
        const unsigned old = xb_add(&bar[XB_XSUB(b.x)], 1u);
        const unsigned gen = old / nloc;
        if (old + 1u == (gen + 1u) * nloc) {
            __builtin_amdgcn_fence(__ATOMIC_RELEASE, "agent");
            asm volatile("s_waitcnt vmcnt(0)" ::: "memory");
            const unsigned og = xb_add(&bar[XB_TOP], 1u);
            const unsigned tg = og / nx;
            if (og + 1u == (tg + 1u) * nx) xb_add(&bar[XB_TOPGEN], 1u);
            else XB_SPIN(xb_ld(&bar[XB_TOPGEN]) == tg, bar);
            __builtin_amdgcn_fence(__ATOMIC_ACQUIRE, "agent");
            xb_add(&bar[XB_XGEN(b.x)], 1u);
            asm volatile("s_waitcnt vmcnt(0)" ::: "memory");
        } else {
            XB_SPIN(xb_ld(&bar[XB_XGEN(b.x)]) == gen, bar);
            __builtin_amdgcn_fence(__ATOMIC_ACQUIRE, "agent");
            asm volatile("s_waitcnt vmcnt(0)" ::: "memory");
        }
    }
    __syncthreads();
}

typedef GAS float gf32; typedef GAS bf16 gbf16; typedef GAS pg8::u32x4 gu32x4; typedef GAS pg8::f32x4 gf32x4; typedef GAS v4u gv4u;
__device__ __forceinline__ pg8::u32x4 pack8(const float (&h)[8]) {
    pg8::u32x4 w; w.x = pg8::cvt_pk_bf16(h[0], h[1]); w.y = pg8::cvt_pk_bf16(h[2], h[3]); w.z = pg8::cvt_pk_bf16(h[4], h[5]); w.w = pg8::cvt_pk_bf16(h[6], h[7]); return w;
}
__device__ __forceinline__ float row_rstd(const gf32* ssq, int row) {
    const gf32x4* p = (const gf32x4*)(ssq + (size_t)row * SSQ_SLOTS); const pg8::f32x4 a = p[0], b = p[1], c = p[2], d = p[3];
    const float s = (((a[0] + a[1]) + (a[2] + a[3])) + ((b[0] + b[1]) + (b[2] + b[3]))) + (((c[0] + c[1]) + (c[2] + c[3])) + ((d[0] + d[1]) + (d[2] + d[3])));
    return rsqrtf(s * (1.0f / D) + EPS);
}

struct EpiUp {
    static constexpr bool PERM = true, AFTER_DRAIN = false;
    gbf16* H; const gf32* ssq;
    __device__ __forceinline__ void operator()(const pg8::f32x4 (&acc)[2][2][4][2], const pg8::Unit& u, int wr, int wc, int fr, int fq) const {
        const int row0 = u.pm * 256 + wr * 64 + fr, col0 = u.pn * 128 + wc * 32 + 8 * fq;
#pragma unroll
        for (int ai = 0; ai < 2; ++ai)
#pragma unroll
            for (int m = 0; m < 4; ++m) {
                const int row = row0 + ai * 128 + m * 16;
                const float rs = row_rstd(ssq, row);
                float h[8];
#pragma unroll
                for (int n = 0; n < 2; ++n)
#pragma unroll
                    for (int i = 0; i < 4; ++i) { const float a = acc[ai][0][m][n][i] * rs, b = acc[ai][1][m][n][i] * rs; h[4 * n + i] = fast_silu(a) * b; }
                *(gu32x4*)(H + (size_t)row * FF + col0) = pack8(h);
            }
    }
};
struct EpiRes {
    static constexpr bool PERM = true, AFTER_DRAIN = false;
    const gf32* xin; gf32* xout; gbf16* xb; gf32* ssq_out; float scale;
    __device__ __forceinline__ void operator()(const pg8::f32x4 (&acc)[2][2][4][2], const pg8::Unit& u, int wr, int wc, int fr, int fq) const {
        const int row0 = u.pm * 256 + wr * 64 + fr, col0 = u.pn * 256 + wc * 32 + 8 * fq;
#pragma unroll
        for (int ai = 0; ai < 2; ++ai)
#pragma unroll
            for (int m = 0; m < 4; ++m) {
                const int row = row0 + ai * 128 + m * 16;
                float ss = 0.f;
#pragma unroll
                for (int bj = 0; bj < 2; ++bj) {
                    const size_t off = (size_t)row * D + col0 + bj * 128;
                    const pg8::f32x4 x0 = *(const gf32x4*)(xin + off) + acc[ai][bj][m][0] * scale, x1 = *(const gf32x4*)(xin + off + 4) + acc[ai][bj][m][1] * scale;
                    *(gf32x4*)(xout + off) = x0; *(gf32x4*)(xout + off + 4) = x1;
                    const float h[8] = {x0[0], x0[1], x0[2], x0[3], x1[0], x1[1], x1[2], x1[3]};
                    *(gu32x4*)(xb + off) = pack8(h);
                    ss += (x0[0] * x0[0] + x0[1] * x0[1]) + (x0[2] * x0[2] + x0[3] * x0[3]) + (x1[0] * x1[0] + x1[1] * x1[1]) + (x1[2] * x1[2] + x1[3] * x1[3]);
                }
                ss += __shfl_xor(ss, 16); ss += __shfl_xor(ss, 32);
                if (fq == 0) ssq_out[(size_t)row * SSQ_SLOTS + u.pn * 4 + wc] = ss;
                asm volatile("" ::: "memory");
            }
    }
};
struct EpiRetIn {
    static constexpr bool PERM = true, AFTER_DRAIN = false;
    gbf16 *Q, *K, *V, *G; const gf32* ssq; const gf32* rope; const gf32* gq; const gf32* gk;
    __device__ __forceinline__ void operator()(const pg8::f32x4 (&acc)[2][2][4][2], const pg8::Unit& u, int wr, int wc, int fr, int fq) const {
        const int row0 = u.pm * 256 + wr * 64 + fr, cl = wc * 32 + 8 * fq, pn = u.pn;
        if (pn < 8) {
            const bool isq = pn < 4; const int h = pn & 3; gbf16* dst = isq ? Q : K; const gf32* gt = (isq ? gq : gk) + h * 128; const float ksc = isq ? 1.0f : 0.0625f;
#pragma unroll
            for (int ai = 0; ai < 2; ++ai)
#pragma unroll
                for (int m = 0; m < 4; ++m) {
                    const int row = row0 + ai * 128 + m * 16;
                    const float dec = row_rstd(ssq, row) * gt[ret_tprime(row)] * ksc;
                    const gf32x4* rp = (const gf32x4*)(rope + ((size_t)pos_index(row) * 128 + cl) * 2);
                    float o1[8], o2[8];
#pragma unroll
                    for (int n = 0; n < 2; ++n) {
                        const pg8::f32x4 cs0 = rp[2 * n], cs1 = rp[2 * n + 1];
                        const float c[4] = {cs0[0], cs0[2], cs1[0], cs1[2]}, s[4] = {cs0[1], cs0[3], cs1[1], cs1[3]};
#pragma unroll
                        for (int i = 0; i < 4; ++i) { const float x1 = acc[ai][0][m][n][i], x2 = acc[ai][1][m][n][i];
                            o1[4 * n + i] = (x1 * c[i] - x2 * s[i]) * dec; o2[4 * n + i] = (x1 * s[i] + x2 * c[i]) * dec; }
                    }
                    gbf16* p = dst + (size_t)row * R_QK + h * R_DK + cl;
                    *(gu32x4*)p = pack8(o1); *(gu32x4*)(p + 128) = pack8(o2);
                }
        } else {
            const bool isv = pn < 16; gbf16* dst = isv ? V : G; const int cb = (isv ? pn - 8 : pn - 16) * 256 + cl;
#pragma unroll
            for (int ai = 0; ai < 2; ++ai)
#pragma unroll
                for (int m = 0; m < 4; ++m) {
                    const int row = row0 + ai * 128 + m * 16;
                    const float rs = row_rstd(ssq, row);
#pragma unroll
                    for (int bj = 0; bj < 2; ++bj) {
                        float h[8];
#pragma unroll
                        for (int n = 0; n < 2; ++n)
#pragma unroll
                            for (int i = 0; i < 4; ++i) { const float v = acc[ai][bj][m][n][i] * rs; h[4 * n + i] = isv ? v : fast_silu(v); }
                        *(gu32x4*)(dst + (size_t)row * R_V + cb + bj * 128) = pack8(h);
                    }
                }
        }
    }
};
template <int SH> __device__ __forceinline__ float dpp_row_shr(float v) { return __builtin_bit_cast(float, __builtin_amdgcn_update_dpp(0, __builtin_bit_cast(int, v), 0x110 + SH, 0xf, 0xf, false)); }
struct EpiHgIn {
    static constexpr bool PERM = true, AFTER_DRAIN = false;
    gbf16 *Qb, *Kt, *V, *G; gf32* EB; const gf32* ssq; const gf32* lb;
    __device__ __forceinline__ void operator()(const pg8::f32x4 (&acc)[2][2][4][2], const pg8::Unit& u, int wr, int wc, int fr, int fq) const {
        const int row0 = u.pm * 256 + wr * 64 + fr, cl = wc * 32 + 8 * fq, pn = u.pn;
        if (pn < 8) {
            const int cb = pn * 128 + cl; const bool samp = u.pm >= MP / 256; const int fl = samp ? (fr & 3) : fr, flast = samp ? 3 : 15;
            float lbv[8];
#pragma unroll
            for (int j = 0; j < 8; ++j) lbv[j] = lb[cb + j];
#pragma unroll
            for (int ai = 0; ai < 2; ++ai)
#pragma unroll
                for (int m = 0; m < 4; ++m) {
                    const int row = row0 + ai * 128 + m * 16;
                    const float rs = row_rstd(ssq, row);
                    float qo[8], ko[8], eb[8];
#pragma unroll
                    for (int n = 0; n < 2; ++n)
#pragma unroll
                        for (int i = 0; i < 4; ++i) {
                            const int j = 4 * n + i;
                            const float qv = acc[ai][0][m][n][i] * rs, zv = acc[ai][1][m][n][i] * rs;
                            const float ez = __expf(-zv), s = __builtin_amdgcn_rcpf(1.0f + ez), sm = ez * s;
                            const float oml = 1.0f - lbv[j];
                            const float f = lbv[j] + oml * s, kk = oml * sm;
                            float b = __logf(f), t;
                            t = dpp_row_shr<1>(b); b += fl >= 1 ? t : 0.f;
                            t = dpp_row_shr<2>(b); b += fl >= 2 ? t : 0.f;
                            t = dpp_row_shr<4>(b); b += fl >= 4 ? t : 0.f;
                            t = dpp_row_shr<8>(b); b += fl >= 8 ? t : 0.f;
                            const float e = __expf(b);
                            qo[j] = fast_silu(qv) * e; ko[j] = kk * __builtin_amdgcn_rcpf(e); eb[j] = e;
                        }
                    *(gu32x4*)(Qb + (size_t)row * D + cb) = pack8(qo);
                    *(gu32x4*)(Kt + (size_t)row * D + cb) = pack8(ko);
                    if (fl == flast) { const int chunk = samp ? 1024 + ((row - MP) >> 2) : (row >> 4); gf32* ep = EB + (size_t)chunk * D + cb;
                        *(gf32x4*)ep = (pg8::f32x4){eb[0], eb[1], eb[2], eb[3]}; *(gf32x4*)(ep + 4) = (pg8::f32x4){eb[4], eb[5], eb[6], eb[7]}; }
                }
        } else {
            const bool isv = pn < 12; gbf16* dst = isv ? V : G; const int cb = (isv ? pn - 8 : pn - 12) * 256 + cl;
#pragma unroll
            for (int ai = 0; ai < 2; ++ai)
#pragma unroll
                for (int m = 0; m < 4; ++m) {
                    const int row = row0 + ai * 128 + m * 16;
                    const float rs = row_rstd(ssq, row);
#pragma unroll
                    for (int bj = 0; bj < 2; ++bj) {
                        float h[8];
#pragma unroll
                        for (int n = 0; n < 2; ++n)
#pragma unroll
                            for (int i = 0; i < 4; ++i) { const float v = acc[ai][bj][m][n][i] * rs; h[4 * n + i] = isv ? v : fast_silu(v); }
                        *(gu32x4*)(dst + (size_t)row * D + cb + bj * 128) = pack8(h);
                    }
                }
        }
    }
};

struct Frame {
    LAS unsigned char* lds;
    volatile LAS unsigned* MISC;
    gu32* ctl;
    int tid, lane, wave, G;
};

__device__ __forceinline__ void transpose_item(const gf32* W, int N, const gf32* kscale, gbf16* WT, int K, int k0, int n0, int dst_row0, LAS float* scr, int lane) {
#pragma unroll 8
    for (int i = 0; i < 32; ++i) { const int kk = 2 * i + (lane >> 5); const float sc = kscale ? kscale[k0 + kk] : 1.0f; scr[kk * 33 + (lane & 31)] = W[(size_t)(k0 + kk) * N + n0 + (lane & 31)] * sc; }
    LDS_WAIT(); asm volatile("" ::: "memory");
    const int c = lane & 7;
#pragma unroll
    for (int j = 0; j < 4; ++j) { const int n = (lane >> 3) + 8 * j; const LAS float* s = scr + (8 * c) * 33 + n;
        v4u o; o.x = pk2(s[0 * 33], s[1 * 33]); o.y = pk2(s[2 * 33], s[3 * 33]); o.z = pk2(s[4 * 33], s[5 * 33]); o.w = pk2(s[6 * 33], s[7 * 33]);
        *(GAS v4u*)(WT + (size_t)(dst_row0 + n) * K + k0 + 8 * c) = o; }
    LDS_WAIT(); asm volatile("" ::: "memory");
}
__device__ __forceinline__ int pair_row(int c, int half_cols) {
    return c < half_cols ? 256 * (c >> 7) + (c & 127) : 256 * ((c - half_cols) >> 7) + 128 + ((c - half_cols) & 127);
}
__device__ __forceinline__ double dpow_int(double base, int e) { double r = 1.0, b = base; while (e > 0) { if (e & 1) r *= b; b *= b; e >>= 1; } return r; }
__device__ __forceinline__ void sincos_reduced(double ang, float& c, float& s) {
    const double k = __builtin_rint(ang * 0.6366197723675814);
    double y = __builtin_fma(-k, 1.5707963267948966, ang); y = __builtin_fma(-k, 6.123233995736766e-17, y);
    const double y2 = y * y;
    double sp = -1.0 / 39916800.0; sp = sp * y2 + 1.0 / 362880.0; sp = sp * y2 - 1.0 / 5040.0; sp = sp * y2 + 1.0 / 120.0; sp = sp * y2 - 1.0 / 6.0; sp = sp * y2 * y + y;
    double cp = 1.0 / 479001600.0; cp = cp * y2 - 1.0 / 3628800.0; cp = cp * y2 + 1.0 / 40320.0; cp = cp * y2 - 1.0 / 720.0; cp = cp * y2 + 1.0 / 24.0; cp = cp * y2 - 0.5; cp = cp * y2 + 1.0;
    const int q = ((int)k) & 3;
    const double cc = (q == 0) ? cp : (q == 1) ? -sp : (q == 2) ? -cp : sp;
    const double ssn = (q == 0) ? sp : (q == 1) ? cp : (q == 2) ? -sp : -cp;
    c = (float)cc; s = (float)ssn;
}
struct PrologueArgs { const gf32 *xp, *xs, *norm_gain, *w_up, *w_down, *ret_w_in, *ret_norm, *ret_w_out, *hg_w_in, *hg_lb, *hg_norm, *hg_w_out; GAS unsigned char* ws; };
__device__ __forceinline__ void p0_prologue(Frame& F, const PrologueArgs& A) {
    LAS float* scr = (LAS float*)(F.lds + RING_OFF + F.wave * 16384);
    const int gw = blockIdx.x * NWAVES + F.wave, NGW = F.G * NWAVES;
    GAS unsigned char* ws = A.ws;
    {
        gf32* X = (gf32*)(ws + WS_X); gbf16* XB = (gbf16*)(ws + WS_XB); gf32* ssq0 = (gf32*)(ws + WS_SSQ);
        for (int row = gw; row < M; row += NGW) {
            const gf32* src = row < MP ? A.xp + (size_t)row * D : A.xs + (size_t)(row - MP) * D;
            const GAS f32x4* xr = (const GAS f32x4*)src + F.lane;
            f32x4 v[4]; float s = 0.f;
#pragma unroll
            for (int j = 0; j < 4; ++j) { v[j] = xr[64 * j]; s += (v[j].x * v[j].x + v[j].y * v[j].y) + (v[j].z * v[j].z + v[j].w * v[j].w); }
            s = wave_sum(s);
            GAS f32x4* xo = (GAS f32x4*)(X + (size_t)row * D) + F.lane; GAS v2u* bo = (GAS v2u*)(XB + (size_t)row * D) + F.lane;
#pragma unroll
            for (int j = 0; j < 4; ++j) { xo[64 * j] = v[j]; v2u w; w.x = pk2(v[j].x, v[j].y); w.y = pk2(v[j].z, v[j].w); bo[64 * j] = w; }
            if (F.lane < SSQ_SLOTS) ssq0[(size_t)row * SSQ_SLOTS + F.lane] = F.lane == 0 ? s : 0.f;
        }
    }
    {
        const int gt = blockIdx.x * (NWAVES * 64) + F.tid, NT = F.G * NWAVES * 64;
        gf32* rope = (gf32*)(ws + WS_ROPE); gf32* tab2 = (gf32*)(ws + WS_TAB2);
        for (int i = gt; i < (TP + TS) * 128; i += NT) {
            const int p = i >> 7, j = i & 127; const double pos = p < TP ? (double)p : (double)(16384 + (p - TP));
            const double inv = dpow_int(0.9305720409296989792906463, j);
            float c, s; sincos_reduced(pos * inv, c, s); rope[2 * i] = c; rope[2 * i + 1] = s;
        }
        for (int i = gt; i < 4 * 128; i += NT) {
            const int h = i >> 7, t = i & 127; const double gam = 1.0 - dpow_int(0.5, 5 + h), g = dpow_int(gam, t + 1);
            tab2[i] = (float)g; tab2[512 + i] = (float)(1.0 / g);
        }
        for (int i = gt; i < 8; i += NT) { const int h = i >> 1; const double gam = 1.0 - dpow_int(0.5, 5 + h); tab2[1024 + i] = (float)dpow_int(gam, (i & 1) ? 4 : R_C); }
        for (int i = gt; i < 2048; i += NT) { const int c = i & 1023; tab2[2048 + i] = (i < 1024) ? 0.0f : 1.0f / (1.0f + expf(A.hg_lb[c] - A.hg_lb[1024 + c])); }
    }
    {
        constexpr int I_UP = 16 * 176, I_DN = 44 * 32, I_RIN = 16 * 192, I_ROUT = 32 * 32, I_HIN = 16 * 128, I_HOUT = 16 * 32, I_J = I_RIN + I_ROUT + I_HIN + I_HOUT;
        constexpr int NITEMS = 8 * I_UP + 8 * I_DN + 2 * I_J;
        for (int it = gw; it < NITEMS; it += NGW) {
            int r = it;
            if (r < 8 * I_UP) { const int idx = r / I_UP; r -= idx * I_UP; const int kb = r / 176, nb = r % 176, l = idx >> 1, f = idx & 1;
                transpose_item(A.w_up + (size_t)idx * D * NUP, NUP, A.norm_gain + (l * 3 + (f ? 2 : 0)) * D, (gbf16*)(ws + WS_W + idx * W_FFN_STRIDE), D, 64 * kb, 32 * nb, pair_row(32 * nb, FF), scr, F.lane); continue; }
            r -= 8 * I_UP;
            if (r < 8 * I_DN) { const int idx = r / I_DN; r -= idx * I_DN; const int kb = r / 32, nb = r % 32;
                transpose_item(A.w_down + (size_t)idx * FF * D, D, nullptr, (gbf16*)(ws + WS_W + idx * W_FFN_STRIDE + W_DOWN_OFF), FF, 64 * kb, 32 * nb, 32 * nb, scr, F.lane); continue; }
            r -= 8 * I_DN;
            const int j = r / I_J; r -= j * I_J;
            if (r < I_RIN) { const int kb = r / 192, nb = r % 192;
                transpose_item(A.ret_w_in + (size_t)j * D * R_NIN, R_NIN, A.norm_gain + ((2 * j) * 3 + 1) * D, (gbf16*)(ws + WS_W + W_RET_BASE + j * W_RET_STRIDE), D, 64 * kb, 32 * nb, 32 * nb, scr, F.lane); continue; }
            r -= I_RIN;
            if (r < I_ROUT) { const int kb = r / 32, nb = r % 32;
                transpose_item(A.ret_w_out + (size_t)j * R_V * D, D, A.ret_norm + j * R_V, (gbf16*)(ws + WS_W + W_RET_BASE + j * W_RET_STRIDE + W_ROUT_OFF), R_V, 64 * kb, 32 * nb, 32 * nb, scr, F.lane); continue; }
            r -= I_ROUT;
            if (r < I_HIN) { const int kb = r / 128, nb = r % 128; const int n0 = 32 * nb;
                transpose_item(A.hg_w_in + (size_t)j * D * G_NIN, G_NIN, A.norm_gain + ((2 * j + 1) * 3 + 1) * D, (gbf16*)(ws + WS_W + W_HG_BASE + j * W_HG_STRIDE), D, 64 * kb, n0, n0 < 2048 ? pair_row(n0, 1024) : n0, scr, F.lane); continue; }
            r -= I_HIN;
            { const int kb = r / 32, nb = r % 32;
                transpose_item(A.hg_w_out + (size_t)j * D * D, D, A.hg_norm + j * D, (gbf16*)(ws + WS_W + W_HG_BASE + j * W_HG_STRIDE + W_HOUT_OFF), D, 64 * kb, 32 * nb, 32 * nb, scr, F.lane); }
        }
    }
}

template <int DK, int DV, int H, int CP>
__device__ __forceinline__ void rec_naive(Frame& F, const gbf16* Qh, const gbf16* Kt, const gbf16* V, const gf32* EB, const gf32* gC, const gf32* S0, gf32* O, gf32* SoutP, gf32* SoutS) {
    constexpr int EG = DV / 64, RD = DK / 8, NU = (NSEQ_P + NSEQ_S) * H * EG;
    LAS float* red = (LAS float*)(F.lds + RING_OFF);
    int vz; asm volatile("v_mov_b32 %0, 0" : "=v"(vz));
    for (int u = blockIdx.x; u < NU; u += F.G) {
        const int seq = u / (H * EG), h = (u / EG) % H, eg = u % EG;
        const bool samp = seq >= NSEQ_P;
        const int T = samp ? TS : TP, C = samp ? 4 : CP;
        const int rowb = samp ? MP + (seq - NSEQ_P) * TS : seq * TP;
        const int d0 = F.wave * RD, e = eg * 64 + F.lane;
        float R[RD];
        if (samp) { const gf32* s0 = S0 + (((size_t)(seq - NSEQ_P) * H + h) * DK + d0) * DV + e;
#pragma unroll
            for (int i = 0; i < RD; ++i) R[i] = s0[(size_t)i * DV]; }
        else {
#pragma unroll
            for (int i = 0; i < RD; ++i) R[i] = 0.f; }
        const float gsc = gC ? gC[h * 2 + (samp ? 1 : 0)] : 1.0f;
        for (int t0 = 0; t0 < T; t0 += 4) {
            const int buf = (t0 >> 2) & 1;
#pragma unroll 1
            for (int tt = 0; tt < 4; ++tt) {
                const int row = rowb + t0 + tt;
                const gv4u* kp = (const gv4u*)(Kt + (size_t)row * (H * DK) + h * DK + d0 + vz);
                const gv4u* qp = (const gv4u*)(Qh + (size_t)row * (H * DK) + h * DK + d0 + vz);
                const float v = bf2f(V[(size_t)row * (H * DV) + h * DV + e]);
                float p = 0.f;
#pragma unroll
                for (int c8 = 0; c8 < RD / 8; ++c8) {
                    const v4u kw = kp[c8], qw = qp[c8];
                    const unsigned kk[4] = {kw.x, kw.y, kw.z, kw.w}, qq[4] = {qw.x, qw.y, qw.z, qw.w};
#pragma unroll
                    for (int w2 = 0; w2 < 4; ++w2) {
                        R[c8 * 8 + 2 * w2] += bflo(kk[w2]) * v; p += bflo(qq[w2]) * R[c8 * 8 + 2 * w2];
                        R[c8 * 8 + 2 * w2 + 1] += bfhi(kk[w2]) * v; p += bfhi(qq[w2]) * R[c8 * 8 + 2 * w2 + 1];
                    }
                }
                red[((buf * 4 + tt) * 8 + F.wave) * 64 + F.lane] = p;
                if (((t0 + tt + 1) % C) == 0) {
                    if (EB) { const int chunk = samp ? 1024 + ((row - MP) >> 2) : (row >> 4); const gf32* ep = EB + (size_t)chunk * (H * DK) + h * DK + d0 + vz;
#pragma unroll
                        for (int i = 0; i < RD; ++i) R[i] *= ep[i]; }
                    else {
#pragma unroll
                        for (int i = 0; i < RD; ++i) R[i] *= gsc; }
                }
            }
            LDS_WAIT(); __syncthreads();
            if (F.tid < 256) { const int tt = F.tid >> 6, l = F.tid & 63; float s = 0.f;
#pragma unroll
                for (int w = 0; w < 8; ++w) s += red[((buf * 4 + tt) * 8 + w) * 64 + l];
                O[(size_t)(rowb + t0 + tt) * (H * DV) + h * DV + eg * 64 + l] = s; }
        }
        gf32* so = samp ? SoutS + (((size_t)(seq - NSEQ_P) * H + h) * DK + d0) * DV + e : SoutP + (((size_t)seq * H + h) * DK + d0) * DV + e;
#pragma unroll
        for (int i = 0; i < RD; ++i) so[(size_t)i * DV] = R[i];
        LDS_WAIT(); __syncthreads();
    }
}

template <int DV>
__device__ __forceinline__ void headnorm_phase(Frame& F, const gf32* O, const gbf16* Gt, gbf16* OB, int ntask  ) {
    constexpr int LPH = DV / 8;
    const int gw = blockIdx.x * NWAVES + F.wave, NGW = F.G * NWAVES;
    for (int t = gw; t < ntask; t += NGW) {
        const size_t base = (size_t)t * 512 + F.lane * 8;
        const f32x4 a = *(const GAS f32x4*)(O + base), b = *(const GAS f32x4*)(O + base + 4);
        const v4u g = *(const gv4u*)(Gt + base);
        float ss = (a.x * a.x + a.y * a.y) + (a.z * a.z + a.w * a.w) + (b.x * b.x + b.y * b.y) + (b.z * b.z + b.w * b.w);
#pragma unroll
        for (int o = 1; o < LPH; o <<= 1) ss += __shfl_xor(ss, o);
        const float rs = rsqrtf(ss * (1.0f / DV) + EPS);
        v4u w; w.x = pk2(a.x * rs * bflo(g.x), a.y * rs * bfhi(g.x)); w.y = pk2(a.z * rs * bflo(g.y), a.w * rs * bfhi(g.y));
        w.z = pk2(b.x * rs * bflo(g.z), b.y * rs * bfhi(g.z)); w.w = pk2(b.z * rs * bflo(g.w), b.w * rs * bfhi(g.w));
        *(gv4u*)(OB + base) = w;
    }
}
__device__ __forceinline__ void final_phase(Frame& F, const gf32* X, const gf32* ssq, const gf32* fn, gf32* out) {
    const int gw = blockIdx.x * NWAVES + F.wave, NGW = F.G * NWAVES;
    for (int row = gw; row < M; row += NGW) {
        const float rs = row_rstd(ssq, row);
        const GAS f32x4* xr = (const GAS f32x4*)(X + (size_t)row * D) + F.lane; const GAS f32x4* gr = (const GAS f32x4*)fn + F.lane; GAS f32x4* yo = (GAS f32x4*)(out + (size_t)row * D) + F.lane;
#pragma unroll
        for (int j = 0; j < 4; ++j) { const f32x4 v = xr[64 * j], g = gr[64 * j]; yo[64 * j] = (f32x4){v.x * rs * g.x, v.y * rs * g.y, v.z * rs * g.z, v.w * rs * g.w}; }
    }
}

#ifndef MK_PER_PHASE_LAUNCH
#define MK_PER_PHASE_LAUNCH 0
#endif
constexpr size_t OUT_Y = 0, OUT_RETP = (size_t)M * D, OUT_RETS = OUT_RETP + (size_t)2 * 8 * 4 * 256 * 512, OUT_HGP = OUT_RETS + (size_t)2 * 128 * 4 * 256 * 512,
                 OUT_HGS = OUT_HGP + (size_t)2 * 8 * 8 * 128 * 128, OUT_END = OUT_HGS + (size_t)2 * 128 * 8 * 128 * 128;
static_assert(OUT_END == 195559424, "output size");

template <class T> __device__ __forceinline__ GAS T* opaque(GAS T* p) { asm volatile("" : "+s"(p)); return p; }
__device__ __forceinline__ Frame local_frame(const Frame& F) {
    Frame L = F; int t = threadIdx.x; asm volatile("" : "+v"(t)); L.tid = t; L.lane = t & 63; L.wave = __builtin_amdgcn_readfirstlane(t >> 6); return L; }
struct Args { const float* in[15]; float* out; unsigned char* ws; int ph_lo, ph_hi; };

#define SSQ_PTR(ws, idx) ((gf32*)((ws) + WS_SSQ) + (size_t)(idx) * M * SSQ_SLOTS)
__device__ __forceinline__ void ffn_up(Frame& F, GAS unsigned char* ws_, int idx, int ssq_idx) {
    GAS unsigned char* ws = opaque(ws_);
    pg8::Gemm g{(const bf16*)(ws + WS_XB), (const bf16*)(ws + WS_W + idx * W_FFN_STRIDE), M, NUP, D};
    pg8::StaticOrder S; S.init(M, NUP, F.G, (int)blockIdx.x);
    EpiUp E{(gbf16*)(ws + WS_HID), SSQ_PTR(ws, ssq_idx)};
    pg8::gemm_phase<EpiUp, pg8::StaticOrder, true, true>(F.lds + RING_OFF, g, S, E);
}
__device__ __forceinline__ void res_gemm(Frame& F, GAS unsigned char* ws_, size_t a_off, size_t w_off, int K, int ssq_idx, float scale) {
    GAS unsigned char* ws = opaque(ws_);
    pg8::Gemm g{(const bf16*)(ws + a_off), (const bf16*)(ws + w_off), M, D, K};
    pg8::StaticOrder S; S.init(M, D, F.G, (int)blockIdx.x);
    EpiRes E{(const gf32*)(ws + WS_X), (gf32*)(ws + WS_X), (gbf16*)(ws + WS_XB), SSQ_PTR(ws, ssq_idx), scale};
    pg8::gemm_phase<EpiRes, pg8::StaticOrder, true, true>(F.lds + RING_OFF, g, S, E);
}
__device__ __forceinline__ void ret_in_gemm(Frame& F, GAS unsigned char* ws_, int j, int ssq_idx) {
    GAS unsigned char* ws = opaque(ws_); const gf32* tab2 = (const gf32*)(ws + WS_TAB2);
    pg8::Gemm g{(const bf16*)(ws + WS_XB), (const bf16*)(ws + WS_W + W_RET_BASE + j * W_RET_STRIDE), M, R_NIN, D};
    pg8::StaticOrder S; S.init(M, R_NIN, F.G, (int)blockIdx.x);
    EpiRetIn E{(gbf16*)(ws + WS_QB), (gbf16*)(ws + WS_KB), (gbf16*)(ws + WS_VB), (gbf16*)(ws + WS_GB), SSQ_PTR(ws, ssq_idx), (const gf32*)(ws + WS_ROPE), tab2, tab2 + 512};
    pg8::gemm_phase<EpiRetIn, pg8::StaticOrder, true, true>(F.lds + RING_OFF, g, S, E);
}
__device__ __forceinline__ void hg_in_gemm(Frame& F, GAS unsigned char* ws_, int j, int ssq_idx) {
    GAS unsigned char* ws = opaque(ws_); const gf32* tab2 = (const gf32*)(ws + WS_TAB2);
    pg8::Gemm g{(const bf16*)(ws + WS_XB), (const bf16*)(ws + WS_W + W_HG_BASE + j * W_HG_STRIDE), M, G_NIN, D};
    pg8::StaticOrder S; S.init(M, G_NIN, F.G, (int)blockIdx.x);
    EpiHgIn E{(gbf16*)(ws + WS_QB), (gbf16*)(ws + WS_KB), (gbf16*)(ws + WS_VB), (gbf16*)(ws + WS_GB), (gf32*)(ws + WS_EB), SSQ_PTR(ws, ssq_idx), tab2 + 2048 + j * 1024};
    pg8::gemm_phase<EpiHgIn, pg8::StaticOrder, true, true>(F.lds + RING_OFF, g, S, E);
}
__device__ __forceinline__ void ret_rec(Frame& F_, GAS unsigned char* ws_, const gf32* st_, gf32* out_, int j) {
    Frame F = local_frame(F_); GAS unsigned char* ws = opaque(ws_); const gf32* st = opaque(st_); gf32* out = opaque(out_);
    rec_naive<R_DK, R_DV, R_H, R_C>(F, (const gbf16*)(ws + WS_QB), (const gbf16*)(ws + WS_KB), (const gbf16*)(ws + WS_VB), nullptr, (const gf32*)(ws + WS_TAB2) + 1024,
                                    st + (size_t)j * NSEQ_S * R_H * R_DK * R_DV, (gf32*)(ws + WS_OF),
                                    out + OUT_RETP + (size_t)j * NSEQ_P * R_H * R_DK * R_DV, out + OUT_RETS + (size_t)j * NSEQ_S * R_H * R_DK * R_DV);
}
__device__ __forceinline__ void hg_rec(Frame& F_, GAS unsigned char* ws_, const gf32* st_, gf32* out_, int j) {
    Frame F = local_frame(F_); GAS unsigned char* ws = opaque(ws_); const gf32* st = opaque(st_); gf32* out = opaque(out_);
    rec_naive<G_DK, G_DV, G_H, G_C>(F, (const gbf16*)(ws + WS_QB), (const gbf16*)(ws + WS_KB), (const gbf16*)(ws + WS_VB), (const gf32*)(ws + WS_EB), nullptr,
                                    st + (size_t)j * NSEQ_S * G_H * G_DK * G_DV, (gf32*)(ws + WS_OF),
                                    out + OUT_HGP + (size_t)j * NSEQ_P * G_H * G_DK * G_DV, out + OUT_HGS + (size_t)j * NSEQ_S * G_H * G_DK * G_DV);
}

__global__ void __launch_bounds__(NWAVES * 64, 2) mk_fwd(Args args) {
    extern __shared__ __attribute__((aligned(16))) unsigned char lds[];
    Frame F;
    F.lds = (LAS unsigned char*)lds;
    F.MISC = (volatile LAS unsigned*)(F.lds + MISC_OFF);
    F.tid = threadIdx.x; F.lane = F.tid & 63; F.wave = __builtin_amdgcn_readfirstlane(F.tid >> 6);
    F.G = gridDim.x;
    GAS unsigned char* ws = (GAS unsigned char*)args.ws;
    F.ctl = (gu32*)(ws + WS_CTL);
    for (int u = F.tid; u < (LDS_BYTES - LDSCTL_OFF) / 4; u += NWAVES * 64) ((LAS unsigned*)(F.lds + LDSCTL_OFF))[u] = 0u;
    __syncthreads();
    int lo = args.ph_lo, hi = args.ph_hi;
    const bool use_bar = (hi - lo) > 1;
    XcdBarrier bar; bar.bar = (unsigned*)(F.ctl + CW_BAR); bar.x = 0; bar.st = nullptr;
    if (use_bar) bar = xcd_barrier_post((unsigned*)(F.ctl + CW_BAR), F.MISC + 8);
#define IN(k) (lo <= (k) && (k) < hi)
#define SEAM(k) do { if (IN(k) && IN((k) + 1)) xcd_barrier(bar); } while (0)

    if (IN(0)) {
        Frame FL = local_frame(F);
        #define GIN(i) ((const gf32*)args.in[i])
        PrologueArgs A{GIN(0), GIN(1), GIN(4), GIN(5), GIN(6), GIN(7), GIN(8), GIN(9), GIN(10), GIN(11), GIN(12), GIN(13), ws};
        p0_prologue(FL, A);
    }
    SEAM(0);

    for (int L = 0; L < 4; ++L) {
        const int pb = 1 + 8 * L, j = L >> 1;
        asm volatile("" : "+s"(lo), "+s"(hi));
        if (IN(pb + 0)) ffn_up(F, ws, 2 * L, 3 * L);
        SEAM(pb + 0);
        if (IN(pb + 1)) res_gemm(F, ws, WS_HID, WS_W + (2 * L) * W_FFN_STRIDE + W_DOWN_OFF, FF, 3 * L + 1, 0.5f);
        SEAM(pb + 1);
        if ((L & 1) == 0) {
            if (IN(pb + 2)) ret_in_gemm(F, ws, j, 3 * L + 1);
            SEAM(pb + 2);
            if (IN(pb + 3)) ret_rec(F, ws, GIN(2), (gf32*)args.out, j);
            SEAM(pb + 3);
            if (IN(pb + 4)) { GAS unsigned char* w = opaque(ws); Frame FL = local_frame(F); headnorm_phase<R_DV>(FL, (const gf32*)(w + WS_OF), (const gbf16*)(w + WS_GB), (gbf16*)(w + WS_OB), M * R_V / 512); }
            SEAM(pb + 4);
            if (IN(pb + 5)) res_gemm(F, ws, WS_OB, WS_W + W_RET_BASE + j * W_RET_STRIDE + W_ROUT_OFF, R_V, 3 * L + 2, 1.0f);
            SEAM(pb + 5);
        } else {
            if (IN(pb + 2)) hg_in_gemm(F, ws, j, 3 * L + 1);
            SEAM(pb + 2);
            if (IN(pb + 3)) hg_rec(F, ws, GIN(3), (gf32*)args.out, j);
            SEAM(pb + 3);
            if (IN(pb + 4)) { GAS unsigned char* w = opaque(ws); Frame FL = local_frame(F); headnorm_phase<G_DV>(FL, (const gf32*)(w + WS_OF), (const gbf16*)(w + WS_GB), (gbf16*)(w + WS_OB), M * D / 512); }
            SEAM(pb + 4);
            if (IN(pb + 5)) res_gemm(F, ws, WS_OB, WS_W + W_HG_BASE + j * W_HG_STRIDE + W_HOUT_OFF, D, 3 * L + 2, 1.0f);
            SEAM(pb + 5);
        }
        if (IN(pb + 6)) ffn_up(F, ws, 2 * L + 1, 3 * L + 2);
        SEAM(pb + 6);
        if (IN(pb + 7)) res_gemm(F, ws, WS_HID, WS_W + (2 * L + 1) * W_FFN_STRIDE + W_DOWN_OFF, FF, 3 * L + 3, 0.5f);
        SEAM(pb + 7);
    }
    if (IN(33)) { GAS unsigned char* w = opaque(ws); Frame FL = local_frame(F); final_phase(FL, (const gf32*)(w + WS_X), SSQ_PTR(w, 12), GIN(14), (gf32*)args.out + OUT_Y); }
#undef IN
#undef SEAM
}

extern "C" void kernel_launch(void* const* d_in, const int* in_sizes, int n_in, void* d_out, int out_size, void* d_ws, size_t ws_size, hipStream_t stream) {
    static int grid = 0;
    if (grid == 0) {
        if (n_in != 15 || (size_t)out_size != OUT_END || ws_size < WS_END) { fprintf(stderr, "kernel_launch: unexpected shapes (n_in %d out %d ws %zu)\n", n_in, out_size, ws_size); grid = -1; return; }
        int dev = 0, cus = 0, per_cu = 0;
        if (hipGetDevice(&dev) != hipSuccess || hipDeviceGetAttribute(&cus, hipDeviceAttributeMultiprocessorCount, dev) != hipSuccess) { grid = -1; return; }
        if (hipFuncSetAttribute((const void*)mk_fwd, hipFuncAttributeMaxDynamicSharedMemorySize, LDS_BYTES) != hipSuccess) { fprintf(stderr, "kernel_launch: hipFuncSetAttribute failed\n"); grid = -1; return; }
        if (hipOccupancyMaxActiveBlocksPerMultiprocessor(&per_cu, (const void*)mk_fwd, NWAVES * 64, LDS_BYTES) != hipSuccess || per_cu < 1) { fprintf(stderr, "kernel_launch: occupancy query says %d\n", per_cu); per_cu = 1; }
        (void)hipGetLastError();
        grid = cus;
    }
    if (grid < 0) return;
    (void)hipMemsetAsync((char*)d_ws + WS_CTL, 0, CTL_ZERO_BYTES, stream);
    Args a{};
    for (int i = 0; i < 15; ++i) a.in[i] = (const float*)d_in[i];
    a.out = (float*)d_out; a.ws = (unsigned char*)d_ws;
#if MK_PER_PHASE_LAUNCH
    for (int p = 0; p < NPHASE; ++p) { a.ph_lo = p; a.ph_hi = p + 1; hipLaunchKernelGGL(mk_fwd, dim3(grid), dim3(NWAVES * 64), LDS_BYTES, stream, a); }
#else
    a.ph_lo = 0; a.ph_hi = NPHASE;
    hipLaunchKernelGGL(mk_fwd, dim3(grid), dim3(NWAVES * 64), LDS_BYTES, stream, a);
#endif
}
```

```cpp
#include <hip/hip_runtime.h>
#include <cstdio>
#include <cstdint>
namespace pg8 {
#define PG8_LAS __attribute__((address_space(3)))
typedef unsigned short bf16_t;
typedef short bf16x8 __attribute__((ext_vector_type(8)));
typedef float f32x4 __attribute__((ext_vector_type(4)));
typedef unsigned u32x4 __attribute__((ext_vector_type(4)));
constexpr int BM = 256, BK = 64, HALF = 128, HTB = HALF * BK * 2  , STAGE_BYTES = 8 * HTB, NXCD = 8, WGM = 8;

__host__ __device__ __forceinline__ int lds_byte(int r, int c) { const int st = (r >> 4) * 2 + (c >> 5), rr = r & 15, cc = c & 31, ob = rr * 64 + cc * 2; return st * 1024 + (ob ^ (((ob >> 9) & 1) << 5)); }
__host__ __device__ __forceinline__ void stage_rc(int b, int& R, int& C) { const int st = b / 1024, sb = b % 1024, swz = sb ^ (((sb >> 9) & 1) << 5); R = (st >> 1) * 16 + swz / 64; C = (st & 1) * 32 + (swz % 64) / 2; }
__host__ __device__ __forceinline__ int perm32(int rho) { const int n = rho >> 4, i = rho & 15; return 8 * (i >> 2) + 4 * n + (i & 3); }

struct Unit { int pm, pn; };
struct Gemm { const bf16_t* A; const bf16_t* Bt; int M, N, K; };

struct StaticOrder {
    int nM, nN, nwg, G, c;
    __host__ __device__ void init(int M, int N, int G_, int c_) { nM = M / BM; nN = N / BM; nwg = nM * nN; G = G_; c = c_; }
    __host__ __device__ bool next(int i, Unit& u) const {
        const long L = (long)i * G + c; if (L >= nwg) return false;
        int wgid = (int)L; { const int q = nwg / NXCD, r = nwg % NXCD, xcd = wgid % NXCD, off = wgid / NXCD; wgid = (xcd < r ? xcd * (q + 1) : r * (q + 1) + (xcd - r) * q) + off; }
        const int nig = WGM * nN, gid = wgid / nig, fm = gid * WGM, gsz = (nM - fm) < WGM ? (nM - fm) : WGM;
        u.pm = fm + ((wgid % nig) % gsz); u.pn = (wgid % nig) / gsz; return true;
    }
    __device__ __forceinline__ void a_ready(const Unit&) const {}
    __device__ __forceinline__ void done(const Unit&) const {}
};

__device__ __forceinline__ unsigned cvt_pk_bf16(float lo, float hi) { unsigned r; asm volatile("v_cvt_pk_bf16_f32 %0, %1, %2" : "=v"(r) : "v"(lo), "v"(hi)); return r; }
template <class Epi, class Sched, bool ALIGN_EPI = false, bool SP2 = false>
__device__ __forceinline__ void gemm_phase(PG8_LAS unsigned char* lds, const Gemm g, const Sched& S, const Epi& E) {
    int tid_ = threadIdx.x; asm volatile("" : "+v"(tid_));
    const int tid = tid_, wid = __builtin_amdgcn_readfirstlane(tid >> 6), lane = tid & 63, wr = wid >> 2, wc = wid & 3, fr = lane & 15, fq = lane >> 4;
    const int K = g.K, nt = K / BK;
    unsigned voffA[2], voffB[2];
#pragma unroll
    for (int i = 0; i < 2; ++i) { int R, C; stage_rc(tid * 16 + i * 8192, R, C); const int Rb = Epi::PERM ? ((R & ~31) + perm32(R & 31)) : R;
        voffA[i] = (unsigned)(R * K + C) * 2u; voffB[i] = (unsigned)(Rb * K + C) * 2u; }
    const size_t kstep = (size_t)(BK * 2);
    const size_t hstep = (size_t)HALF * K * 2;
    const size_t tstep = 2 * hstep;
    const unsigned ldsw = (unsigned)wid * 1024u;
    const int aoff = lds_byte(wr * 64 + fr, fq * 8), boff = lds_byte(wc * 32 + fr, fq * 8);
#define PG8_SA(b, h) (((b) * 2 + (h)) * HTB)
#define PG8_SB(b, h) ((4 + (b) * 2 + (h)) * HTB)
#define PG8_STAGE(bufoff, gbase, voff) do { _Pragma("unroll") for (int _i = 0; _i < 2; ++_i) \
        __builtin_amdgcn_global_load_lds((const unsigned*)((const char*)(gbase) + (voff)[_i]), (PG8_LAS unsigned*)(lds + (bufoff) + ldsw + _i * 8192), 16, 0, 0); } while (0)
#define PG8_LDA(dst, b, h) do { _Pragma("unroll") for (int m = 0; m < 4; ++m) _Pragma("unroll") for (int k = 0; k < 2; ++k) dst[m][k] = *(const PG8_LAS bf16x8*)(lds + PG8_SA(b, h) + aoff + m * 2048 + k * 1024); } while (0)
#define PG8_LDB(dst, b, h) do { _Pragma("unroll") for (int n = 0; n < 2; ++n) _Pragma("unroll") for (int k = 0; k < 2; ++k) dst[n][k] = *(const PG8_LAS bf16x8*)(lds + PG8_SB(b, h) + boff + n * 2048 + k * 1024); } while (0)
#define PG8_MMA(ai, bj, At, Bt) do { __builtin_amdgcn_s_setprio(1); _Pragma("unroll") for (int m = 0; m < 4; ++m) _Pragma("unroll") for (int n = 0; n < 2; ++n) _Pragma("unroll") for (int k = 0; k < 2; ++k) \
        acc[ai][bj][m][n] = __builtin_amdgcn_mfma_f32_16x16x32_bf16(Bt[n][k], At[m][k], acc[ai][bj][m][n], 0, 0, 0); __builtin_amdgcn_s_setprio(0); } while (0)
#define PG8_WAIT_V(n) asm volatile("s_waitcnt vmcnt(" #n ")" ::: "memory")
#define PG8_WAIT_L(n) asm volatile("s_waitcnt lgkmcnt(" #n ")" ::: "memory")
#define PG8_BAR __builtin_amdgcn_s_barrier()
#define PG8_SCHED __builtin_amdgcn_sched_barrier(0)
    Unit cur, nxt; int ui = 0;
    if (!S.next(0, cur)) return;
    f32x4 acc[2][2][4][2];
#pragma unroll
    for (int a = 0; a < 2; ++a)
#pragma unroll
        for (int b = 0; b < 2; ++b)
#pragma unroll
            for (int m = 0; m < 4; ++m)
#pragma unroll
                for (int n = 0; n < 2; ++n) acc[a][b][m][n] = (f32x4){0.f, 0.f, 0.f, 0.f};
    bf16x8 At[4][2], B0[2][2], B1[2][2];
    const char* cA = (const char*)g.A + (size_t)cur.pm * tstep; const char* cB = (const char*)g.Bt + (size_t)cur.pn * tstep;
    S.a_ready(cur);
    if constexpr (SP2) {
        PG8_STAGE(PG8_SB(0, 0), cB, voffB); PG8_STAGE(PG8_SB(0, 1), cB + hstep, voffB); PG8_STAGE(PG8_SA(0, 0), cA, voffA); PG8_STAGE(PG8_SA(0, 1), cA + hstep, voffA);
        if (wr == 1) PG8_BAR;
        PG8_WAIT_V(2); PG8_BAR;
        PG8_STAGE(PG8_SB(1, 0), cB + kstep, voffB); PG8_STAGE(PG8_SA(1, 0), cA + kstep, voffA); PG8_STAGE(PG8_SB(1, 1), cB + hstep + kstep, voffB);
        PG8_WAIT_V(6); PG8_BAR;
    } else {
        PG8_STAGE(PG8_SB(0, 0), cB, voffB); PG8_STAGE(PG8_SA(0, 0), cA, voffA); PG8_STAGE(PG8_SB(0, 1), cB + hstep, voffB); PG8_STAGE(PG8_SA(0, 1), cA + hstep, voffA);
        if (wr == 1) PG8_BAR;
        PG8_WAIT_V(4); PG8_BAR;
        PG8_STAGE(PG8_SB(1, 0), cB + kstep, voffB); PG8_STAGE(PG8_SA(1, 0), cA + kstep, voffA); PG8_STAGE(PG8_SB(1, 1), cB + hstep + kstep, voffB);
        PG8_WAIT_V(6); PG8_BAR;
    }
    for (;;) {
        const bool has_next = S.next(ui + 1, nxt);
        const char* nA = has_next ? (const char*)g.A + (size_t)nxt.pm * tstep : cA; const char* nB = has_next ? (const char*)g.Bt + (size_t)nxt.pn * tstep : cB;
        for (int t = 0; t < nt; t += 2) {
            const bool last = (t == nt - 2);
            const char* a1 = cA + (size_t)(t + 1) * kstep;
            const char* a2 = last ? nA : cA + (size_t)(t + 2) * kstep; const char* b2 = last ? nB : cB + (size_t)(t + 2) * kstep;
            const char* a3 = a2 + kstep; const char* b3 = b2 + kstep;
            if (last && has_next) S.a_ready(nxt);
            if constexpr (SP2) {
            PG8_LDB(B0, 0, 0); PG8_LDB(B1, 0, 1); PG8_SCHED; PG8_LDA(At, 0, 0); PG8_STAGE(PG8_SA(1, 1), a1 + hstep, voffA);
            PG8_WAIT_V(8); PG8_WAIT_L(0); PG8_BAR; PG8_MMA(0, 0, At, B0); PG8_MMA(0, 1, At, B1); PG8_BAR; PG8_SCHED;
            PG8_LDA(At, 0, 1); PG8_STAGE(PG8_SB(0, 0), b2, voffB); PG8_STAGE(PG8_SB(0, 1), b2 + hstep, voffB); PG8_STAGE(PG8_SA(0, 0), a2, voffA);
            PG8_WAIT_V(8); PG8_WAIT_L(0); PG8_BAR; PG8_MMA(1, 0, At, B0); PG8_MMA(1, 1, At, B1); PG8_BAR; PG8_SCHED;
            PG8_LDB(B0, 1, 0); PG8_LDB(B1, 1, 1); PG8_SCHED; PG8_LDA(At, 1, 0); PG8_STAGE(PG8_SA(0, 1), a2 + hstep, voffA);
            PG8_WAIT_V(8); PG8_WAIT_L(0); PG8_BAR; PG8_MMA(0, 0, At, B0); PG8_MMA(0, 1, At, B1); PG8_BAR; PG8_SCHED;
            PG8_LDA(At, 1, 1); PG8_STAGE(PG8_SB(1, 0), b3, voffB); PG8_STAGE(PG8_SB(1, 1), b3 + hstep, voffB); PG8_STAGE(PG8_SA(1, 0), a3, voffA);
            PG8_WAIT_V(8); PG8_WAIT_L(0); PG8_BAR; PG8_MMA(1, 0, At, B0); PG8_MMA(1, 1, At, B1); PG8_BAR; PG8_SCHED;
            } else {
            PG8_LDB(B0, 0, 0); PG8_SCHED; PG8_LDA(At, 0, 0); PG8_STAGE(PG8_SA(1, 1), a1 + hstep, voffA);
            PG8_WAIT_L(8); PG8_BAR; PG8_WAIT_L(0); PG8_MMA(0, 0, At, B0); PG8_BAR; PG8_SCHED;
            PG8_LDB(B1, 0, 1); PG8_STAGE(PG8_SB(0, 0), b2, voffB);
            PG8_BAR; PG8_WAIT_L(0); PG8_MMA(0, 1, At, B1); PG8_BAR;
            PG8_LDA(At, 0, 1); PG8_STAGE(PG8_SA(0, 0), a2, voffA);
            PG8_BAR; PG8_WAIT_L(0); PG8_MMA(1, 0, At, B0); PG8_BAR; PG8_SCHED;
            PG8_STAGE(PG8_SB(0, 1), b2 + hstep, voffB);
            PG8_WAIT_V(6); PG8_BAR; PG8_MMA(1, 1, At, B1); PG8_BAR;
            PG8_LDB(B0, 1, 0); PG8_SCHED; PG8_LDA(At, 1, 0); PG8_STAGE(PG8_SA(0, 1), a2 + hstep, voffA);
            PG8_WAIT_L(8); PG8_BAR; PG8_WAIT_L(0); PG8_MMA(0, 0, At, B0); PG8_BAR; PG8_SCHED;
            PG8_LDB(B1, 1, 1); PG8_STAGE(PG8_SB(1, 0), b3, voffB);
            PG8_BAR; PG8_WAIT_L(0); PG8_MMA(0, 1, At, B1); PG8_BAR;
            PG8_LDA(At, 1, 1); PG8_STAGE(PG8_SA(1, 0), a3, voffA);
            PG8_BAR; PG8_WAIT_L(0); PG8_MMA(1, 0, At, B0); PG8_BAR; PG8_SCHED;
            PG8_STAGE(PG8_SB(1, 1), b3 + hstep, voffB);
            PG8_WAIT_V(6); PG8_BAR; PG8_MMA(1, 1, At, B1); PG8_BAR;
            }
        }
        if constexpr (ALIGN_EPI) { if (wr == 0) PG8_BAR; }
        if constexpr (!Epi::AFTER_DRAIN) { E(acc, cur, wr, wc, fr, fq); S.done(cur); }
        if (!has_next) break;
#pragma unroll
        for (int a = 0; a < 2; ++a)
#pragma unroll
            for (int b = 0; b < 2; ++b)
#pragma unroll
                for (int m = 0; m < 4; ++m)
#pragma unroll
                    for (int n = 0; n < 2; ++n) acc[a][b][m][n] = (f32x4){0.f, 0.f, 0.f, 0.f};
        cur = nxt; cA = nA; cB = nB; ++ui;
        if constexpr (ALIGN_EPI) { if (wr == 1) PG8_BAR; }
    }
    PG8_WAIT_V(0);
    if constexpr (!ALIGN_EPI) { if (wr == 0) PG8_BAR; }
    PG8_BAR;
    if constexpr (Epi::AFTER_DRAIN) { E.fused(acc, cur, wr, wc, fr, fq, lds, wid, lane); S.done(cur); }
#undef PG8_SA
#undef PG8_SB
#undef PG8_STAGE
#undef PG8_LDA
#undef PG8_LDB
#undef PG8_MMA
#undef PG8_WAIT_V
#undef PG8_WAIT_L
#undef PG8_BAR
#undef PG8_SCHED
}
}

constexpr int NWAVES = 8;
constexpr int D = 1024, FF = 2816, NUP = 2 * FF;
constexpr int MP = 8 * 2048, MS = 128 * 4, M = MP + MS;
constexpr int NSEQ_P = 8, TP = 2048, NSEQ_S = 128, TS = 4;
constexpr int R_H = 4, R_DK = 256, R_DV = 512, R_QK = 1024, R_V = 2048, R_NIN = 6144;
constexpr int G_H = 8, G_DK = 128, G_DV = 128, G_NIN = 4096;
constexpr int R_C = 128, G_C = 16;
constexpr float EPS = 1e-6f;
constexpr int NPHASE = 34;

constexpr size_t MiB = 1u << 20;
constexpr size_t WS_CTL = 0, CTL_ZERO_BYTES = 65536;
constexpr int CW_TMO = 0, CW_CODE = 1, CW_BAR = 1024;
constexpr size_t WS_ROPE = 1 * MiB;
constexpr size_t WS_TAB2 = 3 * MiB + 512 * 1024;
constexpr size_t WS_W = 4 * MiB;
constexpr size_t W_FFN_STRIDE = 16 * MiB + 512 * 1024, W_DOWN_OFF = 11 * MiB;
constexpr size_t W_RET_BASE = 132 * MiB, W_RET_STRIDE = 16 * MiB, W_ROUT_OFF = 12 * MiB;
constexpr size_t W_HG_BASE = 164 * MiB, W_HG_STRIDE = 10 * MiB, W_HOUT_OFF = 8 * MiB;
constexpr size_t WS_X = 192 * MiB, WS_XB = 258 * MiB, WS_HID = 291 * MiB, WS_QB = 382 * MiB, WS_KB = 415 * MiB, WS_VB = 448 * MiB, WS_GB = 514 * MiB,
                 WS_OF = 580 * MiB, WS_OB = 712 * MiB, WS_EB = 778 * MiB, WS_SSQ = 784 * MiB, WS_END = 800 * MiB;
constexpr int SSQ_SLOTS = 16;
static_assert(WS_SSQ + 13 * (size_t)M * SSQ_SLOTS * 4 <= WS_END, "ssq region");
static_assert(WS_X + (size_t)M * D * 4 <= WS_XB && WS_XB + (size_t)M * D * 2 <= WS_HID && WS_HID + (size_t)M * FF * 2 <= WS_QB && WS_OF + (size_t)M * R_V * 4 <= WS_OB, "ws map");

constexpr int RING_OFF = 0, RING_BYTES = 131072;
constexpr int LDSCTL_OFF = RING_BYTES, MISC_OFF = LDSCTL_OFF + 320;
constexpr int LDS_BYTES = 147456;

#define GAS __attribute__((address_space(1)))
#define LAS __attribute__((address_space(3)))
typedef unsigned short bf16;
typedef unsigned v4u __attribute__((ext_vector_type(4)));
typedef unsigned v2u __attribute__((ext_vector_type(2)));
typedef float f32x4 __attribute__((ext_vector_type(4)));
typedef GAS unsigned gu32;
#define RLX_AGENT __ATOMIC_RELAXED, __HIP_MEMORY_SCOPE_AGENT
#define LDS_WAIT() asm volatile("s_waitcnt lgkmcnt(0)" ::: "memory")
#define VM_WAIT() asm volatile("s_waitcnt vmcnt(0)" ::: "memory")
__device__ __forceinline__ unsigned f2bf(float f) { unsigned u = __builtin_bit_cast(unsigned, f); return (u + 0x7fffu + ((u >> 16) & 1u)) >> 16; }
__device__ __forceinline__ unsigned pk2(float lo, float hi) { return f2bf(lo) | (f2bf(hi) << 16); }
__device__ __forceinline__ float bf2f(unsigned short b) { return __builtin_bit_cast(float, (unsigned)b << 16); }
__device__ __forceinline__ float bflo(unsigned w) { return __builtin_bit_cast(float, w << 16); }
__device__ __forceinline__ float bfhi(unsigned w) { return __builtin_bit_cast(float, w & 0xffff0000u); }
__device__ __forceinline__ float fast_sigmoid(float x) { return __builtin_amdgcn_rcpf(1.0f + __expf(-x)); }
__device__ __forceinline__ float fast_silu(float x) { return x * fast_sigmoid(x); }
__device__ __forceinline__ float wave_sum(float v) {
#pragma unroll
    for (int o = 1; o < 64; o <<= 1) v += __shfl_xor(v, o);
    return v;
}
__device__ __forceinline__ int pos_index(int row) { return row < MP ? (row & (TP - 1)) : TP + (row & 3); }
__device__ __forceinline__ int ret_tprime(int row) { return row < MP ? (row & (R_C - 1)) : (row & 3); }

#define XB_TMO      128
#define XB_XCNT(j)  (256  + 64 * (j))
#define XB_XSUB(j)  (1280 + 64 * (j))
#define XB_XGEN(j)  (2304 + 64 * (j))
#define XB_TOP      3328
#define XB_TOPGEN   3392
#define XCD_BAR_WORDS 3456
#define XB_SPIN_CAP (1u << 18)

__device__ __forceinline__ unsigned xb_ld(unsigned* p)              { return __hip_atomic_load(p, __ATOMIC_RELAXED, __HIP_MEMORY_SCOPE_AGENT); }
__device__ __forceinline__ unsigned xb_add(unsigned* p, unsigned v) { return __hip_atomic_fetch_add(p, v, __ATOMIC_RELAXED, __HIP_MEMORY_SCOPE_AGENT); }
__device__ __forceinline__ unsigned xb_xcc_id() { return (unsigned)__builtin_amdgcn_s_getreg((3 << 11) | 20) & 0xFu; }
#define XB_SPIN(cond, bar) do { unsigned _sp = 0; while (cond) { __builtin_amdgcn_s_sleep(1); \
    if ((++_sp & 255u) == 0u) { if (xb_ld(&(bar)[XB_TMO])) break; if (_sp > XB_SPIN_CAP) { atomicAdd(&(bar)[XB_TMO], 1u); break; } } } } while (0)

struct XcdBarrier {
    unsigned* bar; unsigned x;
    volatile LAS unsigned* st;
};

__device__ __forceinline__ XcdBarrier xcd_barrier_post(unsigned* bar, volatile LAS unsigned* st) {
    XcdBarrier b; b.bar = bar; b.x = xb_xcc_id(); b.st = st;
    if (threadIdx.x == 0) (void)xb_add(&bar[XB_XCNT(b.x)], 1u);
    return b;
}
__device__ __forceinline__ void xcd_barrier_complete(unsigned* bar, unsigned x, unsigned& nloc, unsigned& nx) {
    const unsigned G = gridDim.x * gridDim.y * gridDim.z;
    unsigned sum, cnt, mine, sp = 0u;
    for (;;) {
        sum = 0u; cnt = 0u; mine = 0u;
#pragma unroll
        for (unsigned j = 0; j < 16; ++j) { const unsigned c = xb_ld(&bar[XB_XCNT(j)]); sum += c; cnt += (c > 0u) ? 1u : 0u; mine = (j == x) ? c : mine; }
        if (sum == G) break;
        __builtin_amdgcn_s_sleep(1);
        if ((++sp & 255u) == 0u) { if (xb_ld(&bar[XB_TMO])) break; if (sp > XB_SPIN_CAP) { atomicAdd(&bar[XB_TMO], 1u); break; } }
    }
    nloc = mine > 0u ? mine : 1u; nx = cnt > 0u ? cnt : 1u;
}

__device__ __forceinline__ void xcd_barrier(const XcdBarrier& b) {
    asm volatile("s_waitcnt vmcnt(0)" ::: "memory");
    __syncthreads();
    if (threadIdx.x == 0) {
        unsigned* bar = b.bar;
        __builtin_amdgcn_s_waitcnt(0);
        unsigned nloc = b.st[0], nx = b.st[1];
        if (nloc == 0u) { xcd_barrier_complete(bar, b.x, nloc, nx); b.st[0] = nloc; b.st[1] = nx; }
        const unsigned old = xb_add(&bar[XB_XSUB(b.x)], 1u);
        const unsigned gen = old / nloc;
        if (old + 1u == (gen + 1u) * nloc) {
            __builtin_amdgcn_fence(__ATOMIC_RELEASE, "agent");
            asm volatile("s_waitcnt vmcnt(0)" ::: "memory");
            const unsigned og = xb_add(&bar[XB_TOP], 1u);
            const unsigned tg = og / nx;
            if (og + 1u == (tg + 1u) * nx) xb_add(&bar[XB_TOPGEN], 1u);
            else XB_SPIN(xb_ld(&bar[XB_TOPGEN]) == tg, bar);
            __builtin_amdgcn_fence(__ATOMIC_ACQUIRE, "agent");
            xb_add(&bar[XB_XGEN(b.x)], 1u);
            asm volatile("s_waitcnt vmcnt(0)" ::: "memory");
        } else {
            XB_SPIN(xb_ld(&bar[XB_XGEN(b.x)]) == gen, bar);
            __builtin_amdgcn_fence(__ATOMIC_ACQUIRE, "agent");
            asm volatile("s_waitcnt vmcnt(0)" ::: "memory");
        }
    }
    __syncthreads();
}

typedef GAS float gf32; typedef GAS bf16 gbf16; typedef GAS pg8::u32x4 gu32x4; typedef GAS pg8::f32x4 gf32x4; typedef GAS v4u gv4u;
__device__ __forceinline__ pg8::u32x4 pack8(const float (&h)[8]) {
    pg8::u32x4 w; w.x = pg8::cvt_pk_bf16(h[0], h[1]); w.y = pg8::cvt_pk_bf16(h[2], h[3]); w.z = pg8::cvt_pk_bf16(h[4], h[5]); w.w = pg8::cvt_pk_bf16(h[6], h[7]); return w;
}
__device__ __forceinline__ float row_rstd(const gf32* ssq, int row) {
    const gf32x4* p = (const gf32x4*)(ssq + (size_t)row * SSQ_SLOTS); const pg8::f32x4 a = p[0], b = p[1], c = p[2], d = p[3];
    const float s = (((a[0] + a[1]) + (a[2] + a[3])) + ((b[0] + b[1]) + (b[2] + b[3]))) + (((c[0] + c[1]) + (c[2] + c[3])) + ((d[0] + d[1]) + (d[2] + d[3])));
    return rsqrtf(s * (1.0f / D) + EPS);
}

struct EpiUp {
    static constexpr bool PERM = true, AFTER_DRAIN = false;
    gbf16* H; const gf32* ssq;
    __device__ __forceinline__ void operator()(const pg8::f32x4 (&acc)[2][2][4][2], const pg8::Unit& u, int wr, int wc, int fr, int fq) const {
        const int row0 = u.pm * 256 + wr * 64 + fr, col0 = u.pn * 128 + wc * 32 + 8 * fq;
#pragma unroll
        for (int ai = 0; ai < 2; ++ai)
#pragma unroll
            for (int m = 0; m < 4; ++m) {
                const int row = row0 + ai * 128 + m * 16;
                const float rs = row_rstd(ssq, row);
                float h[8];
#pragma unroll
                for (int n = 0; n < 2; ++n)
#pragma unroll
                    for (int i = 0; i < 4; ++i) { const float a = acc[ai][0][m][n][i] * rs, b = acc[ai][1][m][n][i] * rs; h[4 * n + i] = fast_silu(a) * b; }
                *(gu32x4*)(H + (size_t)row * FF + col0) = pack8(h);
            }
    }
};
struct EpiRes {
    static constexpr bool PERM = true, AFTER_DRAIN = false;
    const gf32* xin; gf32* xout; gbf16* xb; gf32* ssq_out; float scale;
    __device__ __forceinline__ void operator()(const pg8::f32x4 (&acc)[2][2][4][2], const pg8::Unit& u, int wr, int wc, int fr, int fq) const {
        const int row0 = u.pm * 256 + wr * 64 + fr, col0 = u.pn * 256 + wc * 32 + 8 * fq;
#pragma unroll
        for (int ai = 0; ai < 2; ++ai)
#pragma unroll
            for (int m = 0; m < 4; ++m) {
                const int row = row0 + ai * 128 + m * 16;
                float ss = 0.f;
#pragma unroll
                for (int bj = 0; bj < 2; ++bj) {
                    const size_t off = (size_t)row * D + col0 + bj * 128;
                    const pg8::f32x4 x0 = *(const gf32x4*)(xin + off) + acc[ai][bj][m][0] * scale, x1 = *(const gf32x4*)(xin + off + 4) + acc[ai][bj][m][1] * scale;
                    *(gf32x4*)(xout + off) = x0; *(gf32x4*)(xout + off + 4) = x1;
                    const float h[8] = {x0[0], x0[1], x0[2], x0[3], x1[0], x1[1], x1[2], x1[3]};
                    *(gu32x4*)(xb + off) = pack8(h);
                    ss += (x0[0] * x0[0] + x0[1] * x0[1]) + (x0[2] * x0[2] + x0[3] * x0[3]) + (x1[0] * x1[0] + x1[1] * x1[1]) + (x1[2] * x1[2] + x1[3] * x1[3]);
                }
                ss += __shfl_xor(ss, 16); ss += __shfl_xor(ss, 32);
                if (fq == 0) ssq_out[(size_t)row * SSQ_SLOTS + u.pn * 4 + wc] = ss;
                asm volatile("" ::: "memory");
            }
    }
};
struct EpiRetIn {
    static constexpr bool PERM = true, AFTER_DRAIN = false;
    gbf16 *Q, *K, *V, *G; const gf32* ssq; const gf32* rope; const gf32* gq; const gf32* gk;
    __device__ __forceinline__ void operator()(const pg8::f32x4 (&acc)[2][2][4][2], const pg8::Unit& u, int wr, int wc, int fr, int fq) const {
        const int row0 = u.pm * 256 + wr * 64 + fr, cl = wc * 32 + 8 * fq, pn = u.pn;
        if (pn < 8) {
            const bool isq = pn < 4; const int h = pn & 3; gbf16* dst = isq ? Q : K; const gf32* gt = (isq ? gq : gk) + h * 128; const float ksc = isq ? 1.0f : 0.0625f;
#pragma unroll
            for (int ai = 0; ai < 2; ++ai)
#pragma unroll
                for (int m = 0; m < 4; ++m) {
                    const int row = row0 + ai * 128 + m * 16;
                    const float dec = row_rstd(ssq, row) * gt[ret_tprime(row)] * ksc;
                    const gf32x4* rp = (const gf32x4*)(rope + ((size_t)pos_index(row) * 128 + cl) * 2);
                    float o1[8], o2[8];
#pragma unroll
                    for (int n = 0; n < 2; ++n) {
                        const pg8::f32x4 cs0 = rp[2 * n], cs1 = rp[2 * n + 1];
                        const float c[4] = {cs0[0], cs0[2], cs1[0], cs1[2]}, s[4] = {cs0[1], cs0[3], cs1[1], cs1[3]};
#pragma unroll
                        for (int i = 0; i < 4; ++i) { const float x1 = acc[ai][0][m][n][i], x2 = acc[ai][1][m][n][i];
                            o1[4 * n + i] = (x1 * c[i] - x2 * s[i]) * dec; o2[4 * n + i] = (x1 * s[i] + x2 * c[i]) * dec; }
                    }
                    gbf16* p = dst + (size_t)row * R_QK + h * R_DK + cl;
                    *(gu32x4*)p = pack8(o1); *(gu32x4*)(p + 128) = pack8(o2);
                }
        } else {
            const bool isv = pn < 16; gbf16* dst = isv ? V : G; const int cb = (isv ? pn - 8 : pn - 16) * 256 + cl;
#pragma unroll
            for (int ai = 0; ai < 2; ++ai)
#pragma unroll
                for (int m = 0; m < 4; ++m) {
                    const int row = row0 + ai * 128 + m * 16;
                    const float rs = row_rstd(ssq, row);
#pragma unroll
                    for (int bj = 0; bj < 2; ++bj) {
                        float h[8];
#pragma unroll
                        for (int n = 0; n < 2; ++n)
#pragma unroll
                            for (int i = 0; i < 4; ++i) { const float v = acc[ai][bj][m][n][i] * rs; h[4 * n + i] = isv ? v : fast_silu(v); }
                        *(gu32x4*)(dst + (size_t)row * R_V + cb + bj * 128) = pack8(h);
                    }
                }
        }
    }
};
template <int SH> __device__ __forceinline__ float dpp_row_shr(float v) { return __builtin_bit_cast(float, __builtin_amdgcn_update_dpp(0, __builtin_bit_cast(int, v), 0x110 + SH, 0xf, 0xf, false)); }
struct EpiHgIn {
    static constexpr bool PERM = true, AFTER_DRAIN = false;
    gbf16 *Qb, *Kt, *V, *G; gf32* EB; const gf32* ssq; const gf32* lb;
    __device__ __forceinline__ void operator()(const pg8::f32x4 (&acc)[2][2][4][2], const pg8::Unit& u, int wr, int wc, int fr, int fq) const {
        const int row0 = u.pm * 256 + wr * 64 + fr, cl = wc * 32 + 8 * fq, pn = u.pn;
        if (pn < 8) {
            const int cb = pn * 128 + cl; const bool samp = u.pm >= MP / 256; const int fl = samp ? (fr & 3) : fr, flast = samp ? 3 : 15;
            float lbv[8];
#pragma unroll
            for (int j = 0; j < 8; ++j) lbv[j] = lb[cb + j];
#pragma unroll
            for (int ai = 0; ai < 2; ++ai)
#pragma unroll
                for (int m = 0; m < 4; ++m) {
                    const int row = row0 + ai * 128 + m * 16;
                    const float rs = row_rstd(ssq, row);
                    float qo[8], ko[8], eb[8];
#pragma unroll
                    for (int n = 0; n < 2; ++n)
#pragma unroll
                        for (int i = 0; i < 4; ++i) {
                            const int j = 4 * n + i;
                            const float qv = acc[ai][0][m][n][i] * rs, zv = acc[ai][1][m][n][i] * rs;
                            const float ez = __expf(-zv), s = __builtin_amdgcn_rcpf(1.0f + ez), sm = ez * s;
                            const float oml = 1.0f - lbv[j];
                            const float f = lbv[j] + oml * s, kk = oml * sm;
                            float b = __logf(f), t;
                            t = dpp_row_shr<1>(b); b += fl >= 1 ? t : 0.f;
                            t = dpp_row_shr<2>(b); b += fl >= 2 ? t : 0.f;
                            t = dpp_row_shr<4>(b); b += fl >= 4 ? t : 0.f;
                            t = dpp_row_shr<8>(b); b += fl >= 8 ? t : 0.f;
                            const float e = __expf(b);
                            qo[j] = fast_silu(qv) * e; ko[j] = kk * __builtin_amdgcn_rcpf(e); eb[j] = e;
                        }
                    *(gu32x4*)(Qb + (size_t)row * D + cb) = pack8(qo);
                    *(gu32x4*)(Kt + (size_t)row * D + cb) = pack8(ko);
                    if (fl == flast) { const int chunk = samp ? 1024 + ((row - MP) >> 2) : (row >> 4); gf32* ep = EB + (size_t)chunk * D + cb;
                        *(gf32x4*)ep = (pg8::f32x4){eb[0], eb[1], eb[2], eb[3]}; *(gf32x4*)(ep + 4) = (pg8::f32x4){eb[4], eb[5], eb[6], eb[7]}; }
                }
        } else {
            const bool isv = pn < 12; gbf16* dst = isv ? V : G; const int cb = (isv ? pn - 8 : pn - 12) * 256 + cl;
#pragma unroll
            for (int ai = 0; ai < 2; ++ai)
#pragma unroll
                for (int m = 0; m < 4; ++m) {
                    const int row = row0 + ai * 128 + m * 16;
                    const float rs = row_rstd(ssq, row);
#pragma unroll
                    for (int bj = 0; bj < 2; ++bj) {
                        float h[8];
#pragma unroll
                        for (int n = 0; n < 2; ++n)
#pragma unroll
                            for (int i = 0; i < 4; ++i) { const float v = acc[ai][bj][m][n][i] * rs; h[4 * n + i] = isv ? v : fast_silu(v); }
                        *(gu32x4*)(dst + (size_t)row * D + cb + bj * 128) = pack8(h);
                    }
                }
        }
    }
};

struct Frame {
    LAS unsigned char* lds;
    volatile LAS unsigned* MISC;
    gu32* ctl;
    int tid, lane, wave, G;
};

__device__ __forceinline__ void transpose_item(const gf32* W, int N, const gf32* kscale, gbf16* WT, int K, int k0, int n0, int dst_row0, LAS float* scr, int lane) {
    float wv[32];
#pragma unroll
    for (int i = 0; i < 32; ++i) wv[i] = W[(size_t)(k0 + 2 * i + (lane >> 5)) * N + n0 + (lane & 31)];
#pragma unroll
    for (int i = 0; i < 32; ++i) { const int kk = 2 * i + (lane >> 5); const float sc = kscale ? kscale[k0 + kk] : 1.0f; scr[kk * 33 + (lane & 31)] = wv[i] * sc; }
    LDS_WAIT(); asm volatile("" ::: "memory");
    const int c = lane & 7;
#pragma unroll
    for (int j = 0; j < 4; ++j) { const int n = (lane >> 3) + 8 * j; const LAS float* s = scr + (8 * c) * 33 + n;
        v4u o; o.x = pk2(s[0 * 33], s[1 * 33]); o.y = pk2(s[2 * 33], s[3 * 33]); o.z = pk2(s[4 * 33], s[5 * 33]); o.w = pk2(s[6 * 33], s[7 * 33]);
        *(GAS v4u*)(WT + (size_t)(dst_row0 + n) * K + k0 + 8 * c) = o; }
    LDS_WAIT(); asm volatile("" ::: "memory");
}
__device__ __forceinline__ int pair_row(int c, int half_cols) {
    return c < half_cols ? 256 * (c >> 7) + (c & 127) : 256 * ((c - half_cols) >> 7) + 128 + ((c - half_cols) & 127);
}
__device__ __forceinline__ double dpow_int(double base, int e) { double r = 1.0, b = base; while (e > 0) { if (e & 1) r *= b; b *= b; e >>= 1; } return r; }
__device__ __forceinline__ void sincos_reduced(double ang, float& c, float& s) {
    const double k = __builtin_rint(ang * 0.6366197723675814);
    double y = __builtin_fma(-k, 1.5707963267948966, ang); y = __builtin_fma(-k, 6.123233995736766e-17, y);
    const double y2 = y * y;
    double sp = -1.0 / 39916800.0; sp = sp * y2 + 1.0 / 362880.0; sp = sp * y2 - 1.0 / 5040.0; sp = sp * y2 + 1.0 / 120.0; sp = sp * y2 - 1.0 / 6.0; sp = sp * y2 * y + y;
    double cp = 1.0 / 479001600.0; cp = cp * y2 - 1.0 / 3628800.0; cp = cp * y2 + 1.0 / 40320.0; cp = cp * y2 - 1.0 / 720.0; cp = cp * y2 + 1.0 / 24.0; cp = cp * y2 - 0.5; cp = cp * y2 + 1.0;
    const int q = ((int)k) & 3;
    const double cc = (q == 0) ? cp : (q == 1) ? -sp : (q == 2) ? -cp : sp;
    const double ssn = (q == 0) ? sp : (q == 1) ? cp : (q == 2) ? -sp : -cp;
    c = (float)cc; s = (float)ssn;
}
struct PrologueArgs { const gf32 *xp, *xs, *norm_gain, *w_up, *w_down, *ret_w_in, *ret_norm, *ret_w_out, *hg_w_in, *hg_lb, *hg_norm, *hg_w_out; GAS unsigned char* ws; };
__device__ __forceinline__ void p0_prologue(Frame& F, const PrologueArgs& A) {
    LAS float* scr = (LAS float*)(F.lds + RING_OFF + F.wave * 16384);
    const int gw = blockIdx.x * NWAVES + F.wave, NGW = F.G * NWAVES;
    GAS unsigned char* ws = A.ws;
    {
        gf32* X = (gf32*)(ws + WS_X); gbf16* XB = (gbf16*)(ws + WS_XB); gf32* ssq0 = (gf32*)(ws + WS_SSQ);
        for (int row = gw; row < M; row += NGW) {
            const gf32* src = row < MP ? A.xp + (size_t)row * D : A.xs + (size_t)(row - MP) * D;
            const GAS f32x4* xr = (const GAS f32x4*)src + F.lane;
            f32x4 v[4]; float s = 0.f;
#pragma unroll
            for (int j = 0; j < 4; ++j) { v[j] = xr[64 * j]; s += (v[j].x * v[j].x + v[j].y * v[j].y) + (v[j].z * v[j].z + v[j].w * v[j].w); }
            s = wave_sum(s);
            GAS f32x4* xo = (GAS f32x4*)(X + (size_t)row * D) + F.lane; GAS v2u* bo = (GAS v2u*)(XB + (size_t)row * D) + F.lane;
#pragma unroll
            for (int j = 0; j < 4; ++j) { xo[64 * j] = v[j]; v2u w; w.x = pk2(v[j].x, v[j].y); w.y = pk2(v[j].z, v[j].w); bo[64 * j] = w; }
            if (F.lane < SSQ_SLOTS) ssq0[(size_t)row * SSQ_SLOTS + F.lane] = F.lane == 0 ? s : 0.f;
        }
    }
    {
        const int gt = blockIdx.x * (NWAVES * 64) + F.tid, NT = F.G * NWAVES * 64;
        gf32* rope = (gf32*)(ws + WS_ROPE); gf32* tab2 = (gf32*)(ws + WS_TAB2);
        for (int i = gt; i < (TP + TS) * 128; i += NT) {
            const int p = i >> 7, j = i & 127; const double pos = p < TP ? (double)p : (double)(16384 + (p - TP));
            const double inv = dpow_int(0.9305720409296989792906463, j);
            float c, s; sincos_reduced(pos * inv, c, s); rope[2 * i] = c; rope[2 * i + 1] = s;
        }
        for (int i = gt; i < 4 * 128; i += NT) {
            const int h = i >> 7, t = i & 127; const double gam = 1.0 - dpow_int(0.5, 5 + h), g = dpow_int(gam, t + 1);
            tab2[i] = (float)g; tab2[512 + i] = (float)(1.0 / g);
        }
        for (int i = gt; i < 8; i += NT) { const int h = i >> 1; const double gam = 1.0 - dpow_int(0.5, 5 + h); tab2[1024 + i] = (float)dpow_int(gam, (i & 1) ? 4 : R_C); }
        for (int i = gt; i < 2048; i += NT) { const int c = i & 1023; tab2[2048 + i] = (i < 1024) ? 0.0f : 1.0f / (1.0f + expf(A.hg_lb[c] - A.hg_lb[1024 + c])); }
    }
    {
        constexpr int I_UP = 16 * 176, I_DN = 44 * 32, I_RIN = 16 * 192, I_ROUT = 32 * 32, I_HIN = 16 * 128, I_HOUT = 16 * 32, I_J = I_RIN + I_ROUT + I_HIN + I_HOUT;
        constexpr int NITEMS = 8 * I_UP + 8 * I_DN + 2 * I_J;
        for (int it = gw; it < NITEMS; it += NGW) {
            int r = it;
            if (r < 8 * I_UP) { const int idx = r / I_UP; r -= idx * I_UP; const int kb = r / 176, nb = r % 176, l = idx >> 1, f = idx & 1;
                transpose_item(A.w_up + (size_t)idx * D * NUP, NUP, A.norm_gain + (l * 3 + (f ? 2 : 0)) * D, (gbf16*)(ws + WS_W + idx * W_FFN_STRIDE), D, 64 * kb, 32 * nb, pair_row(32 * nb, FF), scr, F.lane); continue; }
            r -= 8 * I_UP;
            if (r < 8 * I_DN) { const int idx = r / I_DN; r -= idx * I_DN; const int kb = r / 32, nb = r % 32;
                transpose_item(A.w_down + (size_t)idx * FF * D, D, nullptr, (gbf16*)(ws + WS_W + idx * W_FFN_STRIDE + W_DOWN_OFF), FF, 64 * kb, 32 * nb, 32 * nb, scr, F.lane); continue; }
            r -= 8 * I_DN;
            const int j = r / I_J; r -= j * I_J;
            if (r < I_RIN) { const int kb = r / 192, nb = r % 192;
                transpose_item(A.ret_w_in + (size_t)j * D * R_NIN, R_NIN, A.norm_gain + ((2 * j) * 3 + 1) * D, (gbf16*)(ws + WS_W + W_RET_BASE + j * W_RET_STRIDE), D, 64 * kb, 32 * nb, 32 * nb, scr, F.lane); continue; }
            r -= I_RIN;
            if (r < I_ROUT) { const int kb = r / 32, nb = r % 32;
                transpose_item(A.ret_w_out + (size_t)j * R_V * D, D, A.ret_norm + j * R_V, (gbf16*)(ws + WS_W + W_RET_BASE + j * W_RET_STRIDE + W_ROUT_OFF), R_V, 64 * kb, 32 * nb, 32 * nb, scr, F.lane); continue; }
            r -= I_ROUT;
            if (r < I_HIN) { const int kb = r / 128, nb = r % 128; const int n0 = 32 * nb;
                transpose_item(A.hg_w_in + (size_t)j * D * G_NIN, G_NIN, A.norm_gain + ((2 * j + 1) * 3 + 1) * D, (gbf16*)(ws + WS_W + W_HG_BASE + j * W_HG_STRIDE), D, 64 * kb, n0, n0 < 2048 ? pair_row(n0, 1024) : n0, scr, F.lane); continue; }
            r -= I_HIN;
            { const int kb = r / 32, nb = r % 32;
                transpose_item(A.hg_w_out + (size_t)j * D * D, D, A.hg_norm + j * D, (gbf16*)(ws + WS_W + W_HG_BASE + j * W_HG_STRIDE + W_HOUT_OFF), D, 64 * kb, 32 * nb, 32 * nb, scr, F.lane); }
        }
    }
}

template <int DK, int DV, int H, int CP>
__device__ __forceinline__ void rec_naive(Frame& F, const gbf16* Qh, const gbf16* Kt, const gbf16* V, const gf32* EB, const gf32* gC, const gf32* S0, gf32* O, gf32* SoutP, gf32* SoutS, int u0  , int bofs  ) {
    constexpr int EG = DV / 64, RD = DK / 8, NU = (NSEQ_P + NSEQ_S) * H * EG;
    LAS float* red = (LAS float*)(F.lds + RING_OFF);
    int vz; asm volatile("v_mov_b32 %0, 0" : "=v"(vz));
    if ((int)blockIdx.x >= bofs)
    for (int u = u0 + (int)blockIdx.x - bofs; u < NU; u += F.G - bofs) {
        const int seq = u / (H * EG), h = (u / EG) % H, eg = u % EG;
        const bool samp = seq >= NSEQ_P;
        const int T = samp ? TS : TP, C = samp ? 4 : CP;
        const int rowb = samp ? MP + (seq - NSEQ_P) * TS : seq * TP;
        const int d0 = F.wave * RD, e = eg * 64 + F.lane;
        float R[RD];
        if (samp) { const gf32* s0 = S0 + (((size_t)(seq - NSEQ_P) * H + h) * DK + d0) * DV + e;
#pragma unroll
            for (int i = 0; i < RD; ++i) R[i] = s0[(size_t)i * DV]; }
        else {
#pragma unroll
            for (int i = 0; i < RD; ++i) R[i] = 0.f; }
        const float gsc = gC ? gC[h * 2 + (samp ? 1 : 0)] : 1.0f;
        v4u kn[RD / 8], qn[RD / 8]; unsigned short vn;
        { const size_t ro = (size_t)rowb * (H * DK) + h * DK + d0 + vz;
#pragma unroll
          for (int c8 = 0; c8 < RD / 8; ++c8) { kn[c8] = ((const gv4u*)(Kt + ro))[c8]; qn[c8] = ((const gv4u*)(Qh + ro))[c8]; }
          vn = V[(size_t)rowb * (H * DV) + h * DV + e]; }
        for (int t0 = 0; t0 < T; t0 += 4) {
            const int buf = (t0 >> 2) & 1;
#pragma unroll 1
            for (int tt = 0; tt < 4; ++tt) {
                const int row = rowb + t0 + tt;
                v4u kc[RD / 8], qc[RD / 8];
#pragma unroll
                for (int c8 = 0; c8 < RD / 8; ++c8) { kc[c8] = kn[c8]; qc[c8] = qn[c8]; }
                const float v = bf2f(vn);
                { const int rown = (t0 + tt + 1 < T) ? row + 1 : row;
                  const size_t ro = (size_t)rown * (H * DK) + h * DK + d0 + vz;
#pragma unroll
                  for (int c8 = 0; c8 < RD / 8; ++c8) { kn[c8] = ((const gv4u*)(Kt + ro))[c8]; qn[c8] = ((const gv4u*)(Qh + ro))[c8]; }
                  vn = V[(size_t)rown * (H * DV) + h * DV + e]; }
                float p = 0.f;
#pragma unroll
                for (int c8 = 0; c8 < RD / 8; ++c8) {
                    const unsigned kk[4] = {kc[c8].x, kc[c8].y, kc[c8].z, kc[c8].w}, qq[4] = {qc[c8].x, qc[c8].y, qc[c8].z, qc[c8].w};
#pragma unroll
                    for (int w2 = 0; w2 < 4; ++w2) {
                        R[c8 * 8 + 2 * w2] += bflo(kk[w2]) * v; p += bflo(qq[w2]) * R[c8 * 8 + 2 * w2];
                        R[c8 * 8 + 2 * w2 + 1] += bfhi(kk[w2]) * v; p += bfhi(qq[w2]) * R[c8 * 8 + 2 * w2 + 1];
                    }
                }
                red[((buf * 4 + tt) * 8 + F.wave) * 64 + F.lane] = p;
                if (((t0 + tt + 1) % C) == 0) {
                    if (EB) { const int chunk = samp ? 1024 + ((row - MP) >> 2) : (row >> 4); const gf32* ep = EB + (size_t)chunk * (H * DK) + h * DK + d0 + vz;
#pragma unroll
                        for (int i = 0; i < RD; ++i) R[i] *= ep[i]; }
                    else {
#pragma unroll
                        for (int i = 0; i < RD; ++i) R[i] *= gsc; }
                }
            }
            LDS_WAIT(); __syncthreads();
            if (F.tid < 256) { const int tt = F.tid >> 6, l = F.tid & 63; float s = 0.f;
#pragma unroll
                for (int w = 0; w < 8; ++w) s += red[((buf * 4 + tt) * 8 + w) * 64 + l];
                O[(size_t)(rowb + t0 + tt) * (H * DV) + h * DV + eg * 64 + l] = s; }
        }
        gf32* so = samp ? SoutS + (((size_t)(seq - NSEQ_P) * H + h) * DK + d0) * DV + e : SoutP + (((size_t)seq * H + h) * DK + d0) * DV + e;
#pragma unroll
        for (int i = 0; i < RD; ++i) so[(size_t)i * DV] = R[i];
        LDS_WAIT(); __syncthreads();
    }
}

template <int DV>
__device__ __forceinline__ void headnorm_phase(Frame& F, const gf32* O, const gbf16* Gt, gbf16* OB, int ntask  ) {
    constexpr int LPH = DV / 8;
    const int gw = blockIdx.x * NWAVES + F.wave, NGW = F.G * NWAVES;
    for (int t = gw; t < ntask; t += NGW) {
        const size_t base = (size_t)t * 512 + F.lane * 8;
        const f32x4 a = *(const GAS f32x4*)(O + base), b = *(const GAS f32x4*)(O + base + 4);
        const v4u g = *(const gv4u*)(Gt + base);
        float ss = (a.x * a.x + a.y * a.y) + (a.z * a.z + a.w * a.w) + (b.x * b.x + b.y * b.y) + (b.z * b.z + b.w * b.w);
#pragma unroll
        for (int o = 1; o < LPH; o <<= 1) ss += __shfl_xor(ss, o);
        const float rs = rsqrtf(ss * (1.0f / DV) + EPS);
        v4u w; w.x = pk2(a.x * rs * bflo(g.x), a.y * rs * bfhi(g.x)); w.y = pk2(a.z * rs * bflo(g.y), a.w * rs * bfhi(g.y));
        w.z = pk2(b.x * rs * bflo(g.z), b.y * rs * bfhi(g.z)); w.w = pk2(b.z * rs * bflo(g.w), b.w * rs * bfhi(g.w));
        *(gv4u*)(OB + base) = w;
    }
}
__device__ __forceinline__ void final_phase(Frame& F, const gf32* X, const gf32* ssq, const gf32* fn, gf32* out) {
    const int gw = blockIdx.x * NWAVES + F.wave, NGW = F.G * NWAVES;
    for (int row = gw; row < M; row += NGW) {
        const float rs = row_rstd(ssq, row);
        const GAS f32x4* xr = (const GAS f32x4*)(X + (size_t)row * D) + F.lane; const GAS f32x4* gr = (const GAS f32x4*)fn + F.lane; GAS f32x4* yo = (GAS f32x4*)(out + (size_t)row * D) + F.lane;
#pragma unroll
        for (int j = 0; j < 4; ++j) { const f32x4 v = xr[64 * j], g = gr[64 * j]; yo[64 * j] = (f32x4){v.x * rs * g.x, v.y * rs * g.y, v.z * rs * g.z, v.w * rs * g.w}; }
    }
}

typedef float f32x16 __attribute__((ext_vector_type(16)));
typedef short s16x4 __attribute__((ext_vector_type(4)));
typedef short s16x8 __attribute__((ext_vector_type(8)));
typedef __bf16 bf16x2_t __attribute__((ext_vector_type(2)));
typedef float f32x2_t __attribute__((ext_vector_type(2)));
__device__ __forceinline__ unsigned pkbf(float lo, float hi) { const f32x2_t v = {lo, hi}; return __builtin_bit_cast(unsigned, __builtin_convertvector(v, bf16x2_t)); }
#define MFMA32(a, b, c) __builtin_amdgcn_mfma_f32_32x32x16_bf16((a), (b), (c), 0, 0, 0)
__device__ __forceinline__ int swz16(int row) { return ((row & 3) << 2) | ((row >> 2) & 3); }
__device__ __forceinline__ s16x8 tr_pair(LAS unsigned char* p0, LAS unsigned char* p1) {
    const s16x4 lo = __builtin_amdgcn_ds_read_tr16_b64_v4i16((LAS s16x4*)p0), hi = __builtin_amdgcn_ds_read_tr16_b64_v4i16((LAS s16x4*)p1);
    return __builtin_shufflevector(lo, hi, 0, 1, 2, 3, 4, 5, 6, 7);
}
constexpr int RF_KT = 0, RF_VT = 65536, RF_RT = 81920;

__device__ __forceinline__ void ret_fast(Frame& F, const gbf16* Qh, const gbf16* Kt, const gbf16* V, const gf32* gC, gf32* O, gf32* SoutP) {
    LAS unsigned char* L = F.lds + RING_OFF;
    const int wave = F.wave;
    const int tt = wave < 4 ? (wave >> 1) : 3 - ((wave - 4) >> 1), et = wave & 1, dt0 = 2 * (wave >> 1);
    for (int u = blockIdx.x; u < NSEQ_P * R_H * 8; u += F.G) {
        const int pair = (u & 7) * 4 + ((u >> 3) >> 3), sl = (u >> 3) & 7;
        const int b = pair >> 2, h = pair & 3;
        const int rowb = b * TP;
        const float gsc = gC[h * 2];
        int lane0 = F.lane; asm volatile("" : "+v"(lane0));
        f32x16 racc[2];
#pragma unroll
        for (int i = 0; i < 2; ++i)
#pragma unroll
            for (int r = 0; r < 16; ++r) racc[i][r] = 0.f;
        for (int i = F.tid; i < 32768 / 16; i += NWAVES * 64) *(LAS v4u*)(L + RF_RT + i * 16) = (v4u){0u, 0u, 0u, 0u};
#define RF_DMA(c_) do { const int cr0_ = rowb + (c_) * 128; \
            _Pragma("unroll") for (int i_ = 0; i_ < 8; ++i_) { const int row_ = 16 * wave + 2 * i_ + (lane >> 5), ch_ = (lane & 31) ^ swz16(row_); \
                __builtin_amdgcn_global_load_lds((const GAS unsigned*)(Kt + (size_t)(cr0_ + row_) * R_QK + h * R_DK + 8 * ch_), (LAS unsigned*)(L + RF_KT + (16 * wave + 2 * i_) * 512), 16, 0, 0); } \
            _Pragma("unroll") for (int i_ = 0; i_ < 2; ++i_) { const int row_ = 16 * wave + 8 * i_ + (lane >> 3), ch_ = (lane & 7) ^ (((row_ >> 1) & 1) << 2); \
                __builtin_amdgcn_global_load_lds((const GAS unsigned*)(V + (size_t)(cr0_ + row_) * R_V + h * R_DV + sl * 64 + 8 * ch_), (LAS unsigned*)(L + RF_VT + (16 * wave + 8 * i_) * 128), 16, 0, 0); } } while (0)
        { const int lane = lane0; RF_DMA(0); }
        for (int c = 0; c < 16; ++c) {
            const int crow0 = rowb + c * 128;
            int lane = F.lane; asm volatile("" : "+v"(lane));
            const int l31 = lane & 31, hh = lane >> 5, i16 = lane & 15, q4 = i16 >> 2, p4 = i16 & 3, gb = (lane >> 4) & 1;
            const int erow = 32 * et + l31, esw = swz16(erow), ksw = swz16(l31);
            asm volatile("s_waitcnt vmcnt(0) lgkmcnt(0)" ::: "memory"); __builtin_amdgcn_s_barrier(); asm volatile("" ::: "memory");
            s16x8 qf[16];
            {
                const gbf16* qptr = Qh + (size_t)(crow0 + 32 * tt + l31) * R_QK + h * R_DK + 8 * hh;
#pragma unroll
                for (int ks = 0; ks < 16; ++ks) qf[ks] = *(const GAS s16x8*)(qptr + 16 * ks);
            }
            f32x16 oacc;
#pragma unroll
            for (int r = 0; r < 16; ++r) oacc[r] = 0.f;
#pragma unroll
            for (int ks = 0; ks < 16; ++ks) {
                const s16x8 rf = *(const LAS s16x8*)(L + RF_RT + erow * 512 + 16 * ((2 * ks + hh) ^ esw));
                oacc = MFMA32(qf[ks], rf, oacc);
            }
            LAS unsigned char* vbase = L + RF_VT + (4 * hh + q4) * 128 + 16 * ((4 * et + 2 * gb + (p4 >> 1)) ^ (((q4 >> 1) & 1) << 2)) + 8 * (p4 & 1);
#pragma unroll 1
            for (int st = 0; st <= tt; ++st) {
                f32x16 X;
#pragma unroll
                for (int r = 0; r < 16; ++r) X[r] = 0.f;
                LAS unsigned char* kb_ = L + RF_KT + (32 * st + l31) * 512;
#pragma unroll
                for (int ks = 0; ks < 16; ++ks) { const s16x8 kf = *(const LAS s16x8*)(kb_ + 16 * ((2 * ks + hh) ^ ksw)); X = MFMA32(kf, qf[ks], X); }
                if (st == tt) {
#pragma unroll
                    for (int r = 0; r < 16; ++r) { const int sl_ = (r & 3) + 8 * (r >> 2) + 4 * hh; X[r] = sl_ <= l31 ? X[r] : 0.f; }
                }
#pragma unroll
                for (int s2 = 0; s2 < 2; ++s2) {
                    LAS unsigned char* vp = vbase + (2 * st + s2) * 2048;
                    const s16x8 vf = tr_pair(vp, vp + 1024);
                    v4u pk; pk.x = pkbf(X[8 * s2 + 0], X[8 * s2 + 1]); pk.y = pkbf(X[8 * s2 + 2], X[8 * s2 + 3]); pk.z = pkbf(X[8 * s2 + 4], X[8 * s2 + 5]); pk.w = pkbf(X[8 * s2 + 6], X[8 * s2 + 7]);
                    oacc = MFMA32(__builtin_bit_cast(s16x8, pk), vf, oacc);
                }
            }
            {
                gf32* op = O + (size_t)(crow0 + 32 * tt + 4 * hh) * R_V + h * R_DV + sl * 64 + 32 * et + l31;
#pragma unroll
                for (int r = 0; r < 16; ++r) op[(size_t)((r & 3) + 8 * (r >> 2)) * R_V] = oacc[r];
            }
            {
                LAS unsigned char* kt0 = L + RF_KT + (4 * hh + q4) * 512 + 8 * (p4 & 1);
                const int sw0 = (q4 << 2) | hh, sw1 = (q4 << 2) | ((hh + 2) & 3);
                const int cl = 2 * gb + (p4 >> 1);
                const int o00 = 16 * ((4 * dt0 + cl) ^ sw0), o01 = 16 * ((4 * dt0 + cl) ^ sw1) + 8 * 512, o10 = 16 * ((4 * (dt0 + 1) + cl) ^ sw0), o11 = 16 * ((4 * (dt0 + 1) + cl) ^ sw1) + 8 * 512;
#pragma unroll
                for (int k8 = 0; k8 < 8; ++k8) {
                    LAS unsigned char* vp = vbase + k8 * 2048;
                    const s16x8 vf = tr_pair(vp, vp + 1024);
                    const s16x8 ka = tr_pair(kt0 + k8 * 8192 + o00, kt0 + k8 * 8192 + o01);
                    const s16x8 kb2 = tr_pair(kt0 + k8 * 8192 + o10, kt0 + k8 * 8192 + o11);
                    racc[0] = MFMA32(ka, vf, racc[0]);
                    racc[1] = MFMA32(kb2, vf, racc[1]);
                }
            }
#pragma unroll
            for (int i = 0; i < 2; ++i)
#pragma unroll
                for (int r = 0; r < 16; ++r) racc[i][r] *= gsc;
            asm volatile("s_waitcnt lgkmcnt(0)" ::: "memory"); __builtin_amdgcn_s_barrier(); asm volatile("" ::: "memory");
            if (c < 15) {
#pragma unroll
                for (int i = 0; i < 2; ++i)
#pragma unroll
                    for (int g = 0; g < 4; ++g) {
                        v2u w; w.x = pkbf(racc[i][4 * g], racc[i][4 * g + 1]); w.y = pkbf(racc[i][4 * g + 2], racc[i][4 * g + 3]);
                        *(LAS v2u*)(L + RF_RT + erow * 512 + 16 * ((4 * (dt0 + i) + g) ^ esw) + 8 * hh) = w;
                    }
                RF_DMA(c + 1);
            }
        }
#undef RF_DMA
        {
            const int l31 = lane0 & 31, hh = lane0 >> 5;
            gf32* sp = SoutP + ((size_t)(b * R_H + h) * R_DK + 4 * hh) * R_DV + sl * 64 + 32 * et + l31;
#pragma unroll
            for (int i = 0; i < 2; ++i)
#pragma unroll
                for (int r = 0; r < 16; ++r) sp[(size_t)(32 * (dt0 + i) + (r & 3) + 8 * (r >> 2)) * R_DV] = racc[i][r];
        }
        asm volatile("s_waitcnt vmcnt(0) lgkmcnt(0)" ::: "memory"); __builtin_amdgcn_s_barrier(); asm volatile("" ::: "memory");
    }
}

#define MFMA16(a, b, c) __builtin_amdgcn_mfma_f32_16x16x32_bf16((a), (b), (c), 0, 0, 0)
constexpr int HF_KT = 0, HF_QT = 4096, HF_VT = 8192, HF_EB = 12288, HF_SLOT = 13312, HF_NSLOT = 4;
static_assert(HF_SLOT * HF_NSLOT <= RING_BYTES, "hgrn ring");
__device__ __forceinline__ void glds16_asm(const GAS void* gsrc, unsigned lds_dst) {
    unsigned keep;
    asm volatile("s_mov_b32 %0, m0\n\ts_mov_b32 m0, %2\n\ts_nop 0\n\tglobal_load_lds_dwordx4 %1, off\n\ts_mov_b32 m0, %0" : "=&s"(keep) : "v"(gsrc), "s"(lds_dst) : "memory");
}

__device__ __forceinline__ void hg_fast(Frame& F, const gbf16* Qb, const gbf16* Kt, const gbf16* V, const gf32* EB, gf32* O, gf32* SoutP) {
    const int wave = F.wave;
    const unsigned Lb = (unsigned)(size_t)(F.lds + RING_OFF);
    LAS unsigned char* L = F.lds + RING_OFF;
    for (int u = blockIdx.x; u < NSEQ_P * G_H; u += F.G) {
        const int b = u >> 3, h = u & 7;
        int lane = F.lane; asm volatile("" : "+v"(lane));
        const int c16 = lane & 15, quad = lane >> 4;
        const size_t rowb = (size_t)b * TP;
        const int wl = wave & 3, prow = 4 * wl + quad, plc = 2 * ((c16 >> 1) ^ (prow & 7)) + (c16 & 1);
        const gbf16* srcA = (wave < 4 ? Kt : Qb) + (rowb + prow) * D + h * G_DK + 8 * plc;
        const gbf16* srcBv = V + (rowb + prow) * D + h * G_DV + 8 * plc;
        const gf32* srcBe = EB + (rowb >> 4) * D + h * G_DK + 4 * (lane & 31);
        const unsigned dstA = __builtin_amdgcn_readfirstlane(Lb + (wave < 4 ? HF_KT : HF_QT) + wl * 1024), dstB = __builtin_amdgcn_readfirstlane(Lb + (wave < 4 ? HF_VT + wl * 1024 : HF_EB));
#define HF_DMA(ci_) do { const int cc_ = (ci_) < TP / 16 ? (ci_) : TP / 16 - 1; const unsigned so_ = (unsigned)(((ci_) & (HF_NSLOT - 1)) * HF_SLOT); \
            glds16_asm((const GAS void*)(srcA + (size_t)cc_ * 16 * D), dstA + so_); \
            if (wave < 4) glds16_asm((const GAS void*)(srcBv + (size_t)cc_ * 16 * D), dstB + so_); else glds16_asm((const GAS void*)(srcBe + (size_t)cc_ * D), dstB + so_); } while (0)
        pg8::f32x4 R[8];
#pragma unroll
        for (int t = 0; t < 8; ++t) R[t] = (pg8::f32x4){0.f, 0.f, 0.f, 0.f};
        HF_DMA(0); HF_DMA(1);
        __builtin_amdgcn_s_waitcnt(0x0F70);
#pragma unroll 1
        for (int ci = 0; ci < TP / 16; ++ci) {
            if (ci < 2) asm volatile("s_waitcnt vmcnt(0)" ::: "memory"); else asm volatile("s_waitcnt vmcnt(6)" ::: "memory");
            __builtin_amdgcn_s_barrier(); asm volatile("" ::: "memory");
            HF_DMA(ci + 2);
            LAS unsigned char* sb = L + (ci & (HF_NSLOT - 1)) * HF_SLOT;
            v4u kf[4], qf[4]; v2u ktr[8];
#pragma unroll
            for (int kk = 0; kk < 4; ++kk) {
                const int o0 = c16 * 256 + 32 * ((2 * kk) ^ (c16 & 7)) + 8 * quad, o1 = c16 * 256 + 32 * ((2 * kk + 1) ^ (c16 & 7)) + 8 * quad;
                const v2u ka = *(const LAS v2u*)(sb + HF_KT + o0), kb = *(const LAS v2u*)(sb + HF_KT + o1), qa = *(const LAS v2u*)(sb + HF_QT + o0), qb = *(const LAS v2u*)(sb + HF_QT + o1);
                kf[kk] = (v4u){ka.x, ka.y, kb.x, kb.y}; qf[kk] = (v4u){qa.x, qa.y, qb.x, qb.y};
            }
            const int tok = 4 * quad + (c16 >> 2);
            const v2u vtr = __builtin_bit_cast(v2u, __builtin_amdgcn_ds_read_tr16_b64_v4i16((LAS s16x4*)(sb + HF_VT + tok * 256 + 32 * (wave ^ (tok & 7)) + 8 * (c16 & 3))));
#pragma unroll
            for (int t = 0; t < 8; ++t) ktr[t] = __builtin_bit_cast(v2u, __builtin_amdgcn_ds_read_tr16_b64_v4i16((LAS s16x4*)(sb + HF_KT + tok * 256 + 32 * (t ^ (tok & 7)) + 8 * (c16 & 3))));
            __builtin_amdgcn_sched_barrier(0);
            const v4u vB4 = (v4u){vtr.x, vtr.y, 0u, 0u};
            pg8::f32x4 PT = (pg8::f32x4){0.f, 0.f, 0.f, 0.f};
#pragma unroll
            for (int kk = 0; kk < 4; ++kk) PT = MFMA16(__builtin_bit_cast(pg8::bf16x8, kf[kk]), __builtin_bit_cast(pg8::bf16x8, qf[kk]), PT);
            pg8::f32x4 oacc = (pg8::f32x4){0.f, 0.f, 0.f, 0.f};
#pragma unroll
            for (int kk = 0; kk < 4; ++kk) {
                const v4u rB = (v4u){pkbf(R[2 * kk][0], R[2 * kk][1]), pkbf(R[2 * kk][2], R[2 * kk][3]), pkbf(R[2 * kk + 1][0], R[2 * kk + 1][1]), pkbf(R[2 * kk + 1][2], R[2 * kk + 1][3])};
                oacc = MFMA16(__builtin_bit_cast(pg8::bf16x8, qf[kk]), __builtin_bit_cast(pg8::bf16x8, rB), oacc);
            }
#pragma unroll
            for (int t = 0; t < 8; ++t) { const v4u kA = (v4u){ktr[t].x, ktr[t].y, 0u, 0u}; R[t] = MFMA16(__builtin_bit_cast(pg8::bf16x8, kA), __builtin_bit_cast(pg8::bf16x8, vB4), R[t]); }
#pragma unroll
            for (int r = 0; r < 4; ++r) PT[r] = (4 * quad + r) <= c16 ? PT[r] : 0.f;
            const v4u pA = (v4u){pkbf(PT[0], PT[1]), pkbf(PT[2], PT[3]), 0u, 0u};
            oacc = MFMA16(__builtin_bit_cast(pg8::bf16x8, pA), __builtin_bit_cast(pg8::bf16x8, vB4), oacc);
#pragma unroll
            for (int t = 0; t < 8; ++t) { const pg8::f32x4 e4 = *(const LAS pg8::f32x4*)(sb + HF_EB + (16 * t + 4 * quad) * 4); R[t] = R[t] * e4; }
            {
                gf32* op = O + (rowb + (size_t)ci * 16 + 4 * quad) * D + h * G_DV + 16 * wave + c16;
#pragma unroll
                for (int r = 0; r < 4; ++r) op[(size_t)r * D] = oacc[r];
            }
        }
#undef HF_DMA
        {
            gf32* sp = SoutP + ((size_t)(b * G_H + h) * G_DK + 4 * quad) * G_DV + 16 * wave + c16;
#pragma unroll
            for (int t = 0; t < 8; ++t)
#pragma unroll
                for (int r = 0; r < 4; ++r) sp[(size_t)(16 * t + r) * G_DV] = R[t][r];
        }
        asm volatile("s_waitcnt vmcnt(0) lgkmcnt(0)" ::: "memory"); __builtin_amdgcn_s_barrier(); asm volatile("" ::: "memory");
    }
}

__device__ __forceinline__ void mini_res_gemm(Frame& F, const gbf16* A, const gbf16* Wt, int K, const gf32* xin, gf32* xout, gbf16* xb, gf32* ssq_out, float scale) {
    LAS unsigned char* L = F.lds + RING_OFF;
    const int lane = F.lane, wave = F.wave, r16 = lane & 15, quad = lane >> 4;
    const int kw = K >> 3, nks = kw >> 5;
    for (int tile = blockIdx.x; tile < 256; tile += F.G) {
        const int rt = tile >> 4, ct = tile & 15;
        const gbf16* ap = A + (size_t)(MP + 32 * rt + r16) * K + wave * kw + 8 * quad;
        const gbf16* bp = Wt + (size_t)(64 * ct + r16) * K + wave * kw + 8 * quad;
        pg8::f32x4 acc[2][4];
#pragma unroll
        for (int i = 0; i < 2; ++i)
#pragma unroll
            for (int j = 0; j < 4; ++j) acc[i][j] = (pg8::f32x4){0.f, 0.f, 0.f, 0.f};
        v4u fa[2][2], fb[2][4];
#pragma unroll
        for (int i = 0; i < 2; ++i) fa[0][i] = *(const GAS v4u*)(ap + (size_t)(16 * i) * K);
#pragma unroll
        for (int j = 0; j < 4; ++j) fb[0][j] = *(const GAS v4u*)(bp + (size_t)(16 * j) * K);
        for (int ks = 0; ks < nks; ks += 2) {
#pragma unroll
            for (int half = 0; half < 2; ++half) {
                const int kn = ks + half + 1;
                const int ko = 32 * (kn < nks ? kn : nks - 1);
#pragma unroll
                for (int i = 0; i < 2; ++i) fa[half ^ 1][i] = *(const GAS v4u*)(ap + (size_t)(16 * i) * K + ko);
#pragma unroll
                for (int j = 0; j < 4; ++j) fb[half ^ 1][j] = *(const GAS v4u*)(bp + (size_t)(16 * j) * K + ko);
                if (ks + half < nks) {
#pragma unroll
                    for (int i = 0; i < 2; ++i)
#pragma unroll
                        for (int j = 0; j < 4; ++j) acc[i][j] = MFMA16(__builtin_bit_cast(pg8::bf16x8, fb[half][j]), __builtin_bit_cast(pg8::bf16x8, fa[half][i]), acc[i][j]);
                }
            }
        }
#pragma unroll
        for (int i = 0; i < 2; ++i)
#pragma unroll
            for (int j = 0; j < 4; ++j) *(LAS pg8::f32x4*)(L + wave * 8192 + (16 * i + r16) * 256 + (16 * j + 4 * quad) * 4) = acc[i][j];
        LDS_WAIT(); __syncthreads();
        {
            const int row = F.tid >> 4, c4 = F.tid & 15;
            pg8::f32x4 s = *(const LAS pg8::f32x4*)(L + row * 256 + c4 * 16);
#pragma unroll
            for (int w = 1; w < 8; ++w) s = s + *(const LAS pg8::f32x4*)(L + w * 8192 + row * 256 + c4 * 16);
            const size_t off = (size_t)(MP + 32 * rt + row) * D + 64 * ct + 4 * c4;
            const pg8::f32x4 x = *(const gf32x4*)(xin + off) + s * scale;
            *(gf32x4*)(xout + off) = x;
            v2u wb; wb.x = pkbf(x[0], x[1]); wb.y = pkbf(x[2], x[3]);
            *(GAS v2u*)(xb + off) = wb;
            float ss = (x[0] * x[0] + x[1] * x[1]) + (x[2] * x[2] + x[3] * x[3]);
            ss += __shfl_xor(ss, 1); ss += __shfl_xor(ss, 2); ss += __shfl_xor(ss, 4); ss += __shfl_xor(ss, 8);
            if (c4 == 0) ssq_out[(size_t)(MP + 32 * rt + row) * SSQ_SLOTS + ct] = ss;
        }
        LDS_WAIT(); __syncthreads();
    }
}

#ifndef PROBE_MASK
#define PROBE_MASK 0
#endif
#define PREP(type) for (int rep_ = 0; rep_ < 1 + ((PROBE_MASK >> (type)) & 1); ++rep_)
#define PSC(type, s) ((rep_ == 0) ? (s) : 0.0f)
#define PBAR(type) do { if (((PROBE_MASK >> (type)) & 1) && rep_ == 0 && use_bar) xcd_barrier(bar); } while (0)
#ifndef MK_PER_PHASE_LAUNCH
#define MK_PER_PHASE_LAUNCH 0
#endif
constexpr size_t OUT_Y = 0, OUT_RETP = (size_t)M * D, OUT_RETS = OUT_RETP + (size_t)2 * 8 * 4 * 256 * 512, OUT_HGP = OUT_RETS + (size_t)2 * 128 * 4 * 256 * 512,
                 OUT_HGS = OUT_HGP + (size_t)2 * 8 * 8 * 128 * 128, OUT_END = OUT_HGS + (size_t)2 * 128 * 8 * 128 * 128;
static_assert(OUT_END == 195559424, "output size");

template <class T> __device__ __forceinline__ GAS T* opaque(GAS T* p) { asm volatile("" : "+s"(p)); return p; }
__device__ __forceinline__ Frame local_frame(const Frame& F) {
    Frame L = F; int t = threadIdx.x; asm volatile("" : "+v"(t)); L.tid = t; L.lane = t & 63; L.wave = __builtin_amdgcn_readfirstlane(t >> 6); return L; }
struct Args { const float* in[15]; float* out; unsigned char* ws; int ph_lo, ph_hi; };

#define SSQ_PTR(ws, idx) ((gf32*)((ws) + WS_SSQ) + (size_t)(idx) * M * SSQ_SLOTS)
__device__ __forceinline__ void ffn_up(Frame& F, GAS unsigned char* ws_, int idx, int ssq_idx) {
    GAS unsigned char* ws = opaque(ws_);
    pg8::Gemm g{(const bf16*)(ws + WS_XB), (const bf16*)(ws + WS_W + idx * W_FFN_STRIDE), M, NUP, D};
    pg8::StaticOrder S; S.init(M, NUP, F.G, (int)blockIdx.x);
    EpiUp E{(gbf16*)(ws + WS_HID), SSQ_PTR(ws, ssq_idx)};
    pg8::gemm_phase<EpiUp, pg8::StaticOrder, true, true>(F.lds + RING_OFF, g, S, E);
}
__device__ __forceinline__ void res_gemm(Frame& F, GAS unsigned char* ws_, size_t a_off, size_t w_off, int K, int ssq_idx, float scale) {
    GAS unsigned char* ws = opaque(ws_);
    pg8::Gemm g{(const bf16*)(ws + a_off), (const bf16*)(ws + w_off), MP, D, K};
    pg8::StaticOrder S; S.init(MP, D, F.G, (int)blockIdx.x);
    EpiRes E{(const gf32*)(ws + WS_X), (gf32*)(ws + WS_X), (gbf16*)(ws + WS_XB), SSQ_PTR(ws, ssq_idx), scale};
    pg8::gemm_phase<EpiRes, pg8::StaticOrder, true, true>(F.lds + RING_OFF, g, S, E);
    Frame FL = local_frame(F);
    mini_res_gemm(FL, (const gbf16*)(ws + a_off), (const gbf16*)(ws + w_off), K, (const gf32*)(ws + WS_X), (gf32*)(ws + WS_X), (gbf16*)(ws + WS_XB), SSQ_PTR(ws, ssq_idx), scale);
}
__device__ __forceinline__ void ret_in_gemm(Frame& F, GAS unsigned char* ws_, int j, int ssq_idx) {
    GAS unsigned char* ws = opaque(ws_); const gf32* tab2 = (const gf32*)(ws + WS_TAB2);
    pg8::Gemm g{(const bf16*)(ws + WS_XB), (const bf16*)(ws + WS_W + W_RET_BASE + j * W_RET_STRIDE), M, R_NIN, D};
    pg8::StaticOrder S; S.init(M, R_NIN, F.G, (int)blockIdx.x);
    EpiRetIn E{(gbf16*)(ws + WS_QB), (gbf16*)(ws + WS_KB), (gbf16*)(ws + WS_VB), (gbf16*)(ws + WS_GB), SSQ_PTR(ws, ssq_idx), (const gf32*)(ws + WS_ROPE), tab2, tab2 + 512};
    pg8::gemm_phase<EpiRetIn, pg8::StaticOrder, true, true>(F.lds + RING_OFF, g, S, E);
}
__device__ __forceinline__ void hg_in_gemm(Frame& F, GAS unsigned char* ws_, int j, int ssq_idx) {
    GAS unsigned char* ws = opaque(ws_); const gf32* tab2 = (const gf32*)(ws + WS_TAB2);
    pg8::Gemm g{(const bf16*)(ws + WS_XB), (const bf16*)(ws + WS_W + W_HG_BASE + j * W_HG_STRIDE), M, G_NIN, D};
    pg8::StaticOrder S; S.init(M, G_NIN, F.G, (int)blockIdx.x);
    EpiHgIn E{(gbf16*)(ws + WS_QB), (gbf16*)(ws + WS_KB), (gbf16*)(ws + WS_VB), (gbf16*)(ws + WS_GB), (gf32*)(ws + WS_EB), SSQ_PTR(ws, ssq_idx), tab2 + 2048 + j * 1024};
    pg8::gemm_phase<EpiHgIn, pg8::StaticOrder, true, true>(F.lds + RING_OFF, g, S, E);
}
__device__ __forceinline__ void ret_rec(Frame& F_, GAS unsigned char* ws_, const gf32* st_, gf32* out_, int j) {
    Frame F = local_frame(F_); GAS unsigned char* ws = opaque(ws_); const gf32* st = opaque(st_); gf32* out = opaque(out_);
    PREP(13)
    ret_fast(F, (const gbf16*)(ws + WS_QB), (const gbf16*)(ws + WS_KB), (const gbf16*)(ws + WS_VB), (const gf32*)(ws + WS_TAB2) + 1024, (gf32*)(ws + WS_OF),
             out + OUT_RETP + (size_t)j * NSEQ_P * R_H * R_DK * R_DV);
    rec_naive<R_DK, R_DV, R_H, R_C>(F, (const gbf16*)(ws + WS_QB), (const gbf16*)(ws + WS_KB), (const gbf16*)(ws + WS_VB), nullptr, (const gf32*)(ws + WS_TAB2) + 1024,
                                    st + (size_t)j * NSEQ_S * R_H * R_DK * R_DV, (gf32*)(ws + WS_OF),
                                    out + OUT_RETP + (size_t)j * NSEQ_P * R_H * R_DK * R_DV, out + OUT_RETS + (size_t)j * NSEQ_S * R_H * R_DK * R_DV, NSEQ_P * R_H * (R_DV / 64), 0);
}
__device__ __forceinline__ void hg_rec(Frame& F_, GAS unsigned char* ws_, const gf32* st_, gf32* out_, int j) {
    Frame F = local_frame(F_); GAS unsigned char* ws = opaque(ws_); const gf32* st = opaque(st_); gf32* out = opaque(out_);
    PREP(12)
    hg_fast(F, (const gbf16*)(ws + WS_QB), (const gbf16*)(ws + WS_KB), (const gbf16*)(ws + WS_VB), (const gf32*)(ws + WS_EB), (gf32*)(ws + WS_OF),
            out + OUT_HGP + (size_t)j * NSEQ_P * G_H * G_DK * G_DV);
    asm volatile("s_waitcnt vmcnt(0) lgkmcnt(0)" ::: "memory"); __syncthreads();
    rec_naive<G_DK, G_DV, G_H, G_C>(F, (const gbf16*)(ws + WS_QB), (const gbf16*)(ws + WS_KB), (const gbf16*)(ws + WS_VB), (const gf32*)(ws + WS_EB), nullptr,
                                    st + (size_t)j * NSEQ_S * G_H * G_DK * G_DV, (gf32*)(ws + WS_OF),
                                    out + OUT_HGP + (size_t)j * NSEQ_P * G_H * G_DK * G_DV, out + OUT_HGS + (size_t)j * NSEQ_S * G_H * G_DK * G_DV, NSEQ_P * G_H * (G_DV / 64),
                                    F.G > 2 * NSEQ_P * G_H ? NSEQ_P * G_H : 0);
}

__global__ void __launch_bounds__(NWAVES * 64, 2) mk_fwd(Args args) {
    extern __shared__ __attribute__((aligned(16))) unsigned char lds[];
    Frame F;
    F.lds = (LAS unsigned char*)lds;
    F.MISC = (volatile LAS unsigned*)(F.lds + MISC_OFF);
    F.tid = threadIdx.x; F.lane = F.tid & 63; F.wave = __builtin_amdgcn_readfirstlane(F.tid >> 6);
    F.G = gridDim.x;
    GAS unsigned char* ws = (GAS unsigned char*)args.ws;
    F.ctl = (gu32*)(ws + WS_CTL);
    for (int u = F.tid; u < (LDS_BYTES - LDSCTL_OFF) / 4; u += NWAVES * 64) ((LAS unsigned*)(F.lds + LDSCTL_OFF))[u] = 0u;
    __syncthreads();
    int lo = args.ph_lo, hi = args.ph_hi;
    const bool use_bar = (hi - lo) > 1;
    XcdBarrier bar; bar.bar = (unsigned*)(F.ctl + CW_BAR); bar.x = 0; bar.st = nullptr;
    if (use_bar) bar = xcd_barrier_post((unsigned*)(F.ctl + CW_BAR), F.MISC + 8);
#define IN(k) (lo <= (k) && (k) < hi)
#define SEAM(k) do { if (IN(k) && IN((k) + 1)) xcd_barrier(bar); } while (0)

    if (IN(0)) {
        Frame FL = local_frame(F);
        #define GIN(i) ((const gf32*)args.in[i])
        PrologueArgs A{GIN(0), GIN(1), GIN(4), GIN(5), GIN(6), GIN(7), GIN(8), GIN(9), GIN(10), GIN(11), GIN(12), GIN(13), ws};
        PREP(0) { p0_prologue(FL, A); PBAR(0); }
    }
    SEAM(0);

    for (int L = 0; L < 4; ++L) {
        const int pb = 1 + 8 * L, j = L >> 1;
        asm volatile("" : "+s"(lo), "+s"(hi));
        if (IN(pb + 0)) PREP(1) { ffn_up(F, ws, 2 * L, 3 * L); PBAR(1); }
        SEAM(pb + 0);
        if (IN(pb + 1)) PREP(2) { res_gemm(F, ws, WS_HID, WS_W + (2 * L) * W_FFN_STRIDE + W_DOWN_OFF, FF, 3 * L + 1, PSC(2, 0.5f)); PBAR(2); }
        SEAM(pb + 1);
        if ((L & 1) == 0) {
            if (IN(pb + 2)) PREP(3) { ret_in_gemm(F, ws, j, 3 * L + 1); PBAR(3); }
            SEAM(pb + 2);
            if (IN(pb + 3)) PREP(4) { ret_rec(F, ws, GIN(2), (gf32*)args.out, j); PBAR(4); }
            SEAM(pb + 3);
            if (IN(pb + 4)) PREP(5) { PBAR(5); GAS unsigned char* w = opaque(ws); Frame FL = local_frame(F); headnorm_phase<R_DV>(FL, (const gf32*)(w + WS_OF), (const gbf16*)(w + WS_GB), (gbf16*)(w + WS_OB), M * R_V / 512); }
            SEAM(pb + 4);
            if (IN(pb + 5)) PREP(6) { res_gemm(F, ws, WS_OB, WS_W + W_RET_BASE + j * W_RET_STRIDE + W_ROUT_OFF, R_V, 3 * L + 2, PSC(6, 1.0f)); PBAR(6); }
            SEAM(pb + 5);
        } else {
            if (IN(pb + 2)) PREP(7) { hg_in_gemm(F, ws, j, 3 * L + 1); PBAR(7); }
            SEAM(pb + 2);
            if (IN(pb + 3)) PREP(8) { hg_rec(F, ws, GIN(3), (gf32*)args.out, j); PBAR(8); }
            SEAM(pb + 3);
            if (IN(pb + 4)) PREP(9) { PBAR(9); GAS unsigned char* w = opaque(ws); Frame FL = local_frame(F); headnorm_phase<G_DV>(FL, (const gf32*)(w + WS_OF), (const gbf16*)(w + WS_GB), (gbf16*)(w + WS_OB), M * D / 512); }
            SEAM(pb + 4);
            if (IN(pb + 5)) PREP(10) { res_gemm(F, ws, WS_OB, WS_W + W_HG_BASE + j * W_HG_STRIDE + W_HOUT_OFF, D, 3 * L + 2, PSC(10, 1.0f)); PBAR(10); }
            SEAM(pb + 5);
        }
        if (IN(pb + 6)) PREP(1) { ffn_up(F, ws, 2 * L + 1, 3 * L + 2); PBAR(1); }
        SEAM(pb + 6);
        if (IN(pb + 7)) PREP(2) { res_gemm(F, ws, WS_HID, WS_W + (2 * L + 1) * W_FFN_STRIDE + W_DOWN_OFF, FF, 3 * L + 3, PSC(2, 0.5f)); PBAR(2); }
        SEAM(pb + 7);
    }
    if (IN(33)) { GAS unsigned char* w = opaque(ws); Frame FL = local_frame(F); final_phase(FL, (const gf32*)(w + WS_X), SSQ_PTR(w, 12), GIN(14), (gf32*)args.out + OUT_Y); }
#undef IN
#undef SEAM
}

extern "C" void kernel_launch(void* const* d_in, const int* in_sizes, int n_in, void* d_out, int out_size, void* d_ws, size_t ws_size, hipStream_t stream) {
    static int grid = 0;
    if (grid == 0) {
        if (n_in != 15 || (size_t)out_size != OUT_END || ws_size < WS_END) { fprintf(stderr, "kernel_launch: unexpected shapes (n_in %d out %d ws %zu)\n", n_in, out_size, ws_size); grid = -1; return; }
        int dev = 0, cus = 0, per_cu = 0;
        if (hipGetDevice(&dev) != hipSuccess || hipDeviceGetAttribute(&cus, hipDeviceAttributeMultiprocessorCount, dev) != hipSuccess) { grid = -1; return; }
        if (hipFuncSetAttribute((const void*)mk_fwd, hipFuncAttributeMaxDynamicSharedMemorySize, LDS_BYTES) != hipSuccess) { fprintf(stderr, "kernel_launch: hipFuncSetAttribute failed\n"); grid = -1; return; }
        if (hipOccupancyMaxActiveBlocksPerMultiprocessor(&per_cu, (const void*)mk_fwd, NWAVES * 64, LDS_BYTES) != hipSuccess || per_cu < 1) { fprintf(stderr, "kernel_launch: occupancy query says %d\n", per_cu); per_cu = 1; }
        (void)hipGetLastError();
        grid = cus;
    }
    if (grid < 0) return;
    (void)hipMemsetAsync((char*)d_ws + WS_CTL, 0, CTL_ZERO_BYTES, stream);
    Args a{};
    for (int i = 0; i < 15; ++i) a.in[i] = (const float*)d_in[i];
    a.out = (float*)d_out; a.ws = (unsigned char*)d_ws;
#if MK_PER_PHASE_LAUNCH
    for (int p = 0; p < NPHASE; ++p) { a.ph_lo = p; a.ph_hi = p + 1; hipLaunchKernelGGL(mk_fwd, dim3(grid), dim3(NWAVES * 64), LDS_BYTES, stream, a); }
#else
    a.ph_lo = 0; a.ph_hi = NPHASE;
    hipLaunchKernelGGL(mk_fwd, dim3(grid), dim3(NWAVES * 64), LDS_BYTES, stream, a);
#endif
}
```

```cpp
#include <hip/hip_runtime.h>
#include <cstdio>
#include <cstdint>
namespace pg8 {
#define PG8_LAS __attribute__((address_space(3)))
typedef unsigned short bf16_t;
typedef short bf16x8 __attribute__((ext_vector_type(8)));
typedef float f32x4 __attribute__((ext_vector_type(4)));
typedef unsigned u32x4 __attribute__((ext_vector_type(4)));
constexpr int BM = 256, BK = 64, HALF = 128, HTB = HALF * BK * 2  , STAGE_BYTES = 8 * HTB, NXCD = 8, WGM = 8;

__host__ __device__ __forceinline__ int lds_byte(int r, int c) { const int st = (r >> 4) * 2 + (c >> 5), rr = r & 15, cc = c & 31, ob = rr * 64 + cc * 2; return st * 1024 + (ob ^ (((ob >> 9) & 1) << 5)); }
__host__ __device__ __forceinline__ void stage_rc(int b, int& R, int& C) { const int st = b / 1024, sb = b % 1024, swz = sb ^ (((sb >> 9) & 1) << 5); R = (st >> 1) * 16 + swz / 64; C = (st & 1) * 32 + (swz % 64) / 2; }
__host__ __device__ __forceinline__ int perm32(int rho) { const int n = rho >> 4, i = rho & 15; return 8 * (i >> 2) + 4 * n + (i & 3); }

struct Unit { int pm, pn, ord; };
struct Gemm { const bf16_t* A; const bf16_t* Bt; int M, N, K; };

struct StaticOrder {
    int nM, nN, nwg, G, c;
    __host__ __device__ void init(int M, int N, int G_, int c_) { nM = M / BM; nN = N / BM; nwg = nM * nN; G = G_; c = c_; }
    __host__ __device__ bool next(int i, Unit& u) const {
        const long L = (long)i * G + c; if (L >= nwg) return false;
        int wgid = (int)L; { const int q = nwg / NXCD, r = nwg % NXCD, xcd = wgid % NXCD, off = wgid / NXCD; wgid = (xcd < r ? xcd * (q + 1) : r * (q + 1) + (xcd - r) * q) + off; }
        const int nig = WGM * nN, gid = wgid / nig, fm = gid * WGM, gsz = (nM - fm) < WGM ? (nM - fm) : WGM;
        u.pm = fm + ((wgid % nig) % gsz); u.pn = (wgid % nig) / gsz; u.ord = i; return true;
    }
    __device__ __forceinline__ void a_ready(const Unit&) const {}
    __device__ __forceinline__ void done(const Unit&) const {}
};

__device__ __forceinline__ unsigned cvt_pk_bf16(float lo, float hi) { unsigned r; asm volatile("v_cvt_pk_bf16_f32 %0, %1, %2" : "=v"(r) : "v"(lo), "v"(hi)); return r; }
template <class Epi, class Sched, bool ALIGN_EPI = false, bool SP2 = false>
__device__ __forceinline__ void gemm_phase(PG8_LAS unsigned char* lds, const Gemm g, const Sched& S, const Epi& E) {
    int tid_ = threadIdx.x; asm volatile("" : "+v"(tid_));
    const int tid = tid_, wid = __builtin_amdgcn_readfirstlane(tid >> 6), lane = tid & 63, wr = wid >> 2, wc = wid & 3, fr = lane & 15, fq = lane >> 4;
    const int K = g.K, nt = K / BK;
    unsigned voffA[2], voffB[2];
#pragma unroll
    for (int i = 0; i < 2; ++i) { int R, C; stage_rc(tid * 16 + i * 8192, R, C); const int Rb = Epi::PERM ? ((R & ~31) + perm32(R & 31)) : R;
        voffA[i] = (unsigned)(R * K + C) * 2u; voffB[i] = (unsigned)(Rb * K + C) * 2u; }
    const size_t kstep = (size_t)(BK * 2);
    const size_t hstep = (size_t)HALF * K * 2;
    const size_t tstep = 2 * hstep;
    const unsigned ldsw = (unsigned)wid * 1024u;
    const int aoff = lds_byte(wr * 64 + fr, fq * 8), boff = lds_byte(wc * 32 + fr, fq * 8);
#define PG8_SA(b, h) (((b) * 2 + (h)) * HTB)
#define PG8_SB(b, h) ((4 + (b) * 2 + (h)) * HTB)
#define PG8_STAGE(bufoff, gbase, voff) do { _Pragma("unroll") for (int _i = 0; _i < 2; ++_i) \
        __builtin_amdgcn_global_load_lds((const unsigned*)((const char*)(gbase) + (voff)[_i]), (PG8_LAS unsigned*)(lds + (bufoff) + ldsw + _i * 8192), 16, 0, 0); } while (0)
#define PG8_LDA(dst, b, h) do { _Pragma("unroll") for (int m = 0; m < 4; ++m) _Pragma("unroll") for (int k = 0; k < 2; ++k) dst[m][k] = *(const PG8_LAS bf16x8*)(lds + PG8_SA(b, h) + aoff + m * 2048 + k * 1024); } while (0)
#define PG8_LDB(dst, b, h) do { _Pragma("unroll") for (int n = 0; n < 2; ++n) _Pragma("unroll") for (int k = 0; k < 2; ++k) dst[n][k] = *(const PG8_LAS bf16x8*)(lds + PG8_SB(b, h) + boff + n * 2048 + k * 1024); } while (0)
#define PG8_MMA(ai, bj, At, Bt) do { __builtin_amdgcn_s_setprio(1); _Pragma("unroll") for (int m = 0; m < 4; ++m) _Pragma("unroll") for (int n = 0; n < 2; ++n) _Pragma("unroll") for (int k = 0; k < 2; ++k) \
        acc[ai][bj][m][n] = __builtin_amdgcn_mfma_f32_16x16x32_bf16(Bt[n][k], At[m][k], acc[ai][bj][m][n], 0, 0, 0); __builtin_amdgcn_s_setprio(0); } while (0)
#define PG8_WAIT_V(n) asm volatile("s_waitcnt vmcnt(" #n ")" ::: "memory")
#define PG8_WAIT_L(n) asm volatile("s_waitcnt lgkmcnt(" #n ")" ::: "memory")
#define PG8_BAR __builtin_amdgcn_s_barrier()
#define PG8_SCHED __builtin_amdgcn_sched_barrier(0)
    Unit cur, nxt; int ui = 0;
    if (!S.next(0, cur)) return;
    f32x4 acc[2][2][4][2];
#pragma unroll
    for (int a = 0; a < 2; ++a)
#pragma unroll
        for (int b = 0; b < 2; ++b)
#pragma unroll
            for (int m = 0; m < 4; ++m)
#pragma unroll
                for (int n = 0; n < 2; ++n) acc[a][b][m][n] = (f32x4){0.f, 0.f, 0.f, 0.f};
    bf16x8 At[4][2], B0[2][2], B1[2][2];
    const char* cA = (const char*)g.A + (size_t)cur.pm * tstep; const char* cB = (const char*)g.Bt + (size_t)cur.pn * tstep;
    S.a_ready(cur);
    if constexpr (SP2) {
        PG8_STAGE(PG8_SB(0, 0), cB, voffB); PG8_STAGE(PG8_SB(0, 1), cB + hstep, voffB); PG8_STAGE(PG8_SA(0, 0), cA, voffA); PG8_STAGE(PG8_SA(0, 1), cA + hstep, voffA);
        if (wr == 1) PG8_BAR;
        PG8_WAIT_V(2); PG8_BAR;
        PG8_STAGE(PG8_SB(1, 0), cB + kstep, voffB); PG8_STAGE(PG8_SA(1, 0), cA + kstep, voffA); PG8_STAGE(PG8_SB(1, 1), cB + hstep + kstep, voffB);
        PG8_WAIT_V(6); PG8_BAR;
    } else {
        PG8_STAGE(PG8_SB(0, 0), cB, voffB); PG8_STAGE(PG8_SA(0, 0), cA, voffA); PG8_STAGE(PG8_SB(0, 1), cB + hstep, voffB); PG8_STAGE(PG8_SA(0, 1), cA + hstep, voffA);
        if (wr == 1) PG8_BAR;
        PG8_WAIT_V(4); PG8_BAR;
        PG8_STAGE(PG8_SB(1, 0), cB + kstep, voffB); PG8_STAGE(PG8_SA(1, 0), cA + kstep, voffA); PG8_STAGE(PG8_SB(1, 1), cB + hstep + kstep, voffB);
        PG8_WAIT_V(6); PG8_BAR;
    }
    for (;;) {
        const bool has_next = S.next(ui + 1, nxt);
        const char* nA = has_next ? (const char*)g.A + (size_t)nxt.pm * tstep : cA; const char* nB = has_next ? (const char*)g.Bt + (size_t)nxt.pn * tstep : cB;
        for (int t = 0; t < nt; t += 2) {
            const bool last = (t == nt - 2);
            const char* a1 = cA + (size_t)(t + 1) * kstep;
            const char* a2 = last ? nA : cA + (size_t)(t + 2) * kstep; const char* b2 = last ? nB : cB + (size_t)(t + 2) * kstep;
            const char* a3 = a2 + kstep; const char* b3 = b2 + kstep;
            if (last && has_next) S.a_ready(nxt);
            if constexpr (SP2) {
            PG8_LDB(B0, 0, 0); PG8_LDB(B1, 0, 1); PG8_SCHED; PG8_LDA(At, 0, 0); PG8_STAGE(PG8_SA(1, 1), a1 + hstep, voffA);
            PG8_WAIT_V(8); PG8_WAIT_L(0); PG8_BAR; PG8_MMA(0, 0, At, B0); PG8_MMA(0, 1, At, B1); PG8_BAR; PG8_SCHED;
            PG8_LDA(At, 0, 1); PG8_STAGE(PG8_SB(0, 0), b2, voffB); PG8_STAGE(PG8_SB(0, 1), b2 + hstep, voffB); PG8_STAGE(PG8_SA(0, 0), a2, voffA);
            PG8_WAIT_V(8); PG8_WAIT_L(0); PG8_BAR; PG8_MMA(1, 0, At, B0); PG8_MMA(1, 1, At, B1); PG8_BAR; PG8_SCHED;
            PG8_LDB(B0, 1, 0); PG8_LDB(B1, 1, 1); PG8_SCHED; PG8_LDA(At, 1, 0); PG8_STAGE(PG8_SA(0, 1), a2 + hstep, voffA);
            PG8_WAIT_V(8); PG8_WAIT_L(0); PG8_BAR; PG8_MMA(0, 0, At, B0); PG8_MMA(0, 1, At, B1); PG8_BAR; PG8_SCHED;
            PG8_LDA(At, 1, 1); PG8_STAGE(PG8_SB(1, 0), b3, voffB); PG8_STAGE(PG8_SB(1, 1), b3 + hstep, voffB); PG8_STAGE(PG8_SA(1, 0), a3, voffA);
            PG8_WAIT_V(8); PG8_WAIT_L(0); PG8_BAR; PG8_MMA(1, 0, At, B0); PG8_MMA(1, 1, At, B1); PG8_BAR; PG8_SCHED;
            if constexpr (Epi::KSCALE) { if (((t + 2) & 7) == 0) E.kscale(acc, cur, (t + 2) >> 3, wr, fr); }
            } else {
            PG8_LDB(B0, 0, 0); PG8_SCHED; PG8_LDA(At, 0, 0); PG8_STAGE(PG8_SA(1, 1), a1 + hstep, voffA);
            PG8_WAIT_L(8); PG8_BAR; PG8_WAIT_L(0); PG8_MMA(0, 0, At, B0); PG8_BAR; PG8_SCHED;
            PG8_LDB(B1, 0, 1); PG8_STAGE(PG8_SB(0, 0), b2, voffB);
            PG8_BAR; PG8_WAIT_L(0); PG8_MMA(0, 1, At, B1); PG8_BAR;
            PG8_LDA(At, 0, 1); PG8_STAGE(PG8_SA(0, 0), a2, voffA);
            PG8_BAR; PG8_WAIT_L(0); PG8_MMA(1, 0, At, B0); PG8_BAR; PG8_SCHED;
            PG8_STAGE(PG8_SB(0, 1), b2 + hstep, voffB);
            PG8_WAIT_V(6); PG8_BAR; PG8_MMA(1, 1, At, B1); PG8_BAR;
            PG8_LDB(B0, 1, 0); PG8_SCHED; PG8_LDA(At, 1, 0); PG8_STAGE(PG8_SA(0, 1), a2 + hstep, voffA);
            PG8_WAIT_L(8); PG8_BAR; PG8_WAIT_L(0); PG8_MMA(0, 0, At, B0); PG8_BAR; PG8_SCHED;
            PG8_LDB(B1, 1, 1); PG8_STAGE(PG8_SB(1, 0), b3, voffB);
            PG8_BAR; PG8_WAIT_L(0); PG8_MMA(0, 1, At, B1); PG8_BAR;
            PG8_LDA(At, 1, 1); PG8_STAGE(PG8_SA(1, 0), a3, voffA);
            PG8_BAR; PG8_WAIT_L(0); PG8_MMA(1, 0, At, B0); PG8_BAR; PG8_SCHED;
            PG8_STAGE(PG8_SB(1, 1), b3 + hstep, voffB);
            PG8_WAIT_V(6); PG8_BAR; PG8_MMA(1, 1, At, B1); PG8_BAR;
            }
        }
        if constexpr (ALIGN_EPI) { if (wr == 0) PG8_BAR; }
        if constexpr (!Epi::AFTER_DRAIN) { E(acc, cur, wr, wc, fr, fq); S.done(cur); }
        if (!has_next) break;
#pragma unroll
        for (int a = 0; a < 2; ++a)
#pragma unroll
            for (int b = 0; b < 2; ++b)
#pragma unroll
                for (int m = 0; m < 4; ++m)
#pragma unroll
                    for (int n = 0; n < 2; ++n) acc[a][b][m][n] = (f32x4){0.f, 0.f, 0.f, 0.f};
        cur = nxt; cA = nA; cB = nB; ++ui;
        if constexpr (ALIGN_EPI) { if (wr == 1) PG8_BAR; }
    }
    PG8_WAIT_V(0);
    if constexpr (!ALIGN_EPI) { if (wr == 0) PG8_BAR; }
    PG8_BAR;
    if constexpr (Epi::AFTER_DRAIN) { E.fused(acc, cur, wr, wc, fr, fq, lds, wid, lane); S.done(cur); }
#undef PG8_SA
#undef PG8_SB
#undef PG8_STAGE
#undef PG8_LDA
#undef PG8_LDB
#undef PG8_MMA
#undef PG8_WAIT_V
#undef PG8_WAIT_L
#undef PG8_BAR
#undef PG8_SCHED
}
}

constexpr int NWAVES = 8;
constexpr int D = 1024, FF = 2816, NUP = 2 * FF;
constexpr int MP = 8 * 2048, MS = 128 * 4, M = MP + MS;
constexpr int NSEQ_P = 8, TP = 2048, NSEQ_S = 128, TS = 4;
constexpr int R_H = 4, R_DK = 256, R_DV = 512, R_QK = 1024, R_V = 2048, R_NIN = 6144;
constexpr int G_H = 8, G_DK = 128, G_DV = 128, G_NIN = 4096;
constexpr int R_C = 64, G_C = 16;
constexpr float EPS = 1e-6f;
constexpr int NPHASE = 34;

constexpr size_t MiB = 1u << 20;
constexpr size_t WS_CTL = 0, CTL_ZERO_BYTES = 65536;
constexpr int CW_TMO = 0, CW_CODE = 1, CW_BAR = 1024;
constexpr size_t WS_ROPE = 1 * MiB;
constexpr size_t WS_TAB2 = 3 * MiB + 512 * 1024;
constexpr size_t WS_W = 4 * MiB;
constexpr size_t W_FFN_STRIDE = 16 * MiB + 512 * 1024, W_DOWN_OFF = 11 * MiB;
constexpr size_t W_RET_BASE = 132 * MiB, W_RET_STRIDE = 16 * MiB, W_ROUT_OFF = 12 * MiB;
constexpr size_t W_HG_BASE = 164 * MiB, W_HG_STRIDE = 10 * MiB, W_HOUT_OFF = 8 * MiB;
constexpr size_t WS_X = 192 * MiB, WS_XB = 258 * MiB, WS_HID = 291 * MiB, WS_QB = 382 * MiB, WS_KB = 415 * MiB, WS_VB = 448 * MiB, WS_GB = 514 * MiB,
                 WS_OF = 580 * MiB, WS_OB = 712 * MiB, WS_EB = 778 * MiB, WS_SSQ = 784 * MiB, WS_SSQO = 800 * MiB, WS_RT8 = 805 * MiB, WS_END = 806 * MiB;
constexpr int SSQ_SLOTS = 16;
static_assert(WS_SSQ + 13 * (size_t)M * SSQ_SLOTS * 4 <= WS_END, "ssq region");
static_assert(WS_X + (size_t)M * D * 4 <= WS_XB && WS_XB + (size_t)M * D * 2 <= WS_HID && WS_HID + (size_t)M * FF * 2 <= WS_QB && WS_OF + (size_t)M * R_V * 4 <= WS_OB, "ws map");

constexpr int RING_OFF = 0, RING_BYTES = 162816;
constexpr int LDSCTL_OFF = RING_BYTES, MISC_OFF = LDSCTL_OFF + 320;
constexpr int LDS_BYTES = 163840;

#define GAS __attribute__((address_space(1)))
#define LAS __attribute__((address_space(3)))
typedef unsigned short bf16;
typedef unsigned v4u __attribute__((ext_vector_type(4)));
typedef unsigned v2u __attribute__((ext_vector_type(2)));
typedef float f32x4 __attribute__((ext_vector_type(4)));
typedef GAS unsigned gu32;
#define RLX_AGENT __ATOMIC_RELAXED, __HIP_MEMORY_SCOPE_AGENT
#define LDS_WAIT() asm volatile("s_waitcnt lgkmcnt(0)" ::: "memory")
#define VM_WAIT() asm volatile("s_waitcnt vmcnt(0)" ::: "memory")
__device__ __forceinline__ unsigned f2bf(float f) { unsigned u = __builtin_bit_cast(unsigned, f); return (u + 0x7fffu + ((u >> 16) & 1u)) >> 16; }
__device__ __forceinline__ unsigned pk2(float lo, float hi) { return f2bf(lo) | (f2bf(hi) << 16); }
__device__ __forceinline__ float bf2f(unsigned short b) { return __builtin_bit_cast(float, (unsigned)b << 16); }
__device__ __forceinline__ float bflo(unsigned w) { return __builtin_bit_cast(float, w << 16); }
__device__ __forceinline__ float bfhi(unsigned w) { return __builtin_bit_cast(float, w & 0xffff0000u); }
__device__ __forceinline__ float fast_sigmoid(float x) { return __builtin_amdgcn_rcpf(1.0f + __expf(-x)); }
__device__ __forceinline__ float fast_silu(float x) { return x * fast_sigmoid(x); }
__device__ __forceinline__ float wave_sum(float v) {
#pragma unroll
    for (int o = 1; o < 64; o <<= 1) v += __shfl_xor(v, o);
    return v;
}
__device__ __forceinline__ int pos_index(int row) { return row < MP ? (row & (TP - 1)) : TP + (row & 3); }
__device__ __forceinline__ int ret_tprime(int row) { return row < MP ? (row & (R_C - 1)) : (row & 3); }

#define XB_TMO      128
#define XB_XCNT(j)  (256  + 64 * (j))
#define XB_XSUB(j)  (1280 + 64 * (j))
#define XB_XGEN(j)  (2304 + 64 * (j))
#define XB_TOP      3328
#define XB_TOPGEN   3392
#define XCD_BAR_WORDS 3456
#define XB_SPIN_CAP (1u << 18)

__device__ __forceinline__ unsigned xb_ld(unsigned* p)              { return __hip_atomic_load(p, __ATOMIC_RELAXED, __HIP_MEMORY_SCOPE_AGENT); }
__device__ __forceinline__ unsigned xb_add(unsigned* p, unsigned v) { return __hip_atomic_fetch_add(p, v, __ATOMIC_RELAXED, __HIP_MEMORY_SCOPE_AGENT); }
__device__ __forceinline__ unsigned xb_xcc_id() { return (unsigned)__builtin_amdgcn_s_getreg((3 << 11) | 20) & 0xFu; }
#define XB_SPIN(cond, bar) do { unsigned _sp = 0; while (cond) { __builtin_amdgcn_s_sleep(1); \
    if ((++_sp & 255u) == 0u) { if (xb_ld(&(bar)[XB_TMO])) break; if (_sp > XB_SPIN_CAP) { atomicAdd(&(bar)[XB_TMO], 1u); break; } } } } while (0)

struct XcdBarrier {
    unsigned* bar; unsigned x;
    volatile LAS unsigned* st;
};

__device__ __forceinline__ XcdBarrier xcd_barrier_post(unsigned* bar, volatile LAS unsigned* st) {
    XcdBarrier b; b.bar = bar; b.x = xb_xcc_id(); b.st = st;
    if (threadIdx.x == 0) (void)xb_add(&bar[XB_XCNT(b.x)], 1u);
    return b;
}
__device__ __forceinline__ void xcd_barrier_complete(unsigned* bar, unsigned x, unsigned& nloc, unsigned& nx) {
    const unsigned G = gridDim.x * gridDim.y * gridDim.z;
    unsigned sum, cnt, mine, sp = 0u;
    for (;;) {
        sum = 0u; cnt = 0u; mine = 0u;
#pragma unroll
        for (unsigned j = 0; j < 16; ++j) { const unsigned c = xb_ld(&bar[XB_XCNT(j)]); sum += c; cnt += (c > 0u) ? 1u : 0u; mine = (j == x) ? c : mine; }
        if (sum == G) break;
        __builtin_amdgcn_s_sleep(1);
        if ((++sp & 255u) == 0u) { if (xb_ld(&bar[XB_TMO])) break; if (sp > XB_SPIN_CAP) { atomicAdd(&bar[XB_TMO], 1u); break; } }
    }
    nloc = mine > 0u ? mine : 1u; nx = cnt > 0u ? cnt : 1u;
}

__device__ __forceinline__ void xcd_barrier(const XcdBarrier& b) {
    asm volatile("s_waitcnt vmcnt(0)" ::: "memory");
    __syncthreads();
    if (threadIdx.x == 0) {
        unsigned* bar = b.bar;
        __builtin_amdgcn_s_waitcnt(0);
        unsigned nloc = b.st[0], nx = b.st[1];
        if (nloc == 0u) { xcd_barrier_complete(bar, b.x, nloc, nx); b.st[0] = nloc; b.st[1] = nx; }
        const unsigned old = xb_add(&bar[XB_XSUB(b.x)], 1u);
        const unsigned gen = old / nloc;
        if (old + 1u == (gen + 1u) * nloc) {
            __builtin_amdgcn_fence(__ATOMIC_RELEASE, "agent");
            asm volatile("s_waitcnt vmcnt(0)" ::: "memory");
            const unsigned og = xb_add(&bar[XB_TOP], 1u);
            const unsigned tg = og / nx;
            if (og + 1u == (tg + 1u) * nx) xb_add(&bar[XB_TOPGEN], 1u);
            else XB_SPIN(xb_ld(&bar[XB_TOPGEN]) == tg, bar);
            __builtin_amdgcn_fence(__ATOMIC_ACQUIRE, "agent");
            xb_add(&bar[XB_XGEN(b.x)], 1u);
            asm volatile("s_waitcnt vmcnt(0)" ::: "memory");
        } else {
            XB_SPIN(xb_ld(&bar[XB_XGEN(b.x)]) == gen, bar);
            __builtin_amdgcn_fence(__ATOMIC_ACQUIRE, "agent");
            asm volatile("s_waitcnt vmcnt(0)" ::: "memory");
        }
    }
    __syncthreads();
}

typedef GAS float gf32; typedef GAS bf16 gbf16; typedef GAS pg8::u32x4 gu32x4; typedef GAS pg8::f32x4 gf32x4; typedef GAS v4u gv4u;
__device__ __forceinline__ pg8::u32x4 pack8(const float (&h)[8]) {
    pg8::u32x4 w; w.x = pg8::cvt_pk_bf16(h[0], h[1]); w.y = pg8::cvt_pk_bf16(h[2], h[3]); w.z = pg8::cvt_pk_bf16(h[4], h[5]); w.w = pg8::cvt_pk_bf16(h[6], h[7]); return w;
}
__device__ __forceinline__ float row_rstd(const gf32* ssq, int row) {
    const gf32x4* p = (const gf32x4*)(ssq + (size_t)row * SSQ_SLOTS); const pg8::f32x4 a = p[0], b = p[1], c = p[2], d = p[3];
    const float s = (((a[0] + a[1]) + (a[2] + a[3])) + ((b[0] + b[1]) + (b[2] + b[3]))) + (((c[0] + c[1]) + (c[2] + c[3])) + ((d[0] + d[1]) + (d[2] + d[3])));
    return rsqrtf(s * (1.0f / D) + EPS);
}
constexpr int LRS_OFF = 131072 + 4096;
static_assert(LRS_OFF + 7 * 1024 <= RING_BYTES, "rstd staging");
template <class Sched> __device__ __forceinline__ const LAS float* stage_row_rstd(LAS unsigned char* lds, const Sched& S, const gf32* ssq, int tid) {
    LAS float* lrs = (LAS float*)(lds + LRS_OFF);
    asm volatile("" : "+v"(tid));
    if (tid < 256) { pg8::Unit u; for (int i = 0; S.next(i, u); ++i) lrs[i * 256 + tid] = row_rstd(ssq, u.pm * 256 + tid); }
    LDS_WAIT(); __syncthreads();
    return lrs;
}

struct EpiUp {
    static constexpr bool PERM = true, AFTER_DRAIN = false, KSCALE = false;
    gbf16* H; const LAS float* lrs;
    __device__ __forceinline__ void operator()(const pg8::f32x4 (&acc)[2][2][4][2], const pg8::Unit& u, int wr, int wc, int fr, int fq) const {
        const int row0 = u.pm * 256 + wr * 64 + fr, col0 = u.pn * 128 + wc * 32 + 8 * fq;
#pragma unroll
        for (int ai = 0; ai < 2; ++ai)
#pragma unroll
            for (int m = 0; m < 4; ++m) {
                const int row = row0 + ai * 128 + m * 16;
                const float rs = lrs[u.ord * 256 + (row - u.pm * 256)];
                typedef float f32x2 __attribute__((ext_vector_type(2)));
                const float k1s = rs * -1.4426950408889634f, rs2s = rs * rs;
                const f32x2 k1 = (f32x2){k1s, k1s}, rs2 = (f32x2){rs2s, rs2s}, one = (f32x2){1.0f, 1.0f};
                float h[8];
#pragma unroll
                for (int n = 0; n < 2; ++n)
#pragma unroll
                    for (int p = 0; p < 2; ++p) {
                        const f32x2 a = (f32x2){acc[ai][0][m][n][2 * p], acc[ai][0][m][n][2 * p + 1]}, b = (f32x2){acc[ai][1][m][n][2 * p], acc[ai][1][m][n][2 * p + 1]};
                        const f32x2 t = a * k1;
                        const f32x2 d = (f32x2){__builtin_amdgcn_exp2f(t.x), __builtin_amdgcn_exp2f(t.y)} + one;
                        const f32x2 r = (f32x2){__builtin_amdgcn_rcpf(d.x), __builtin_amdgcn_rcpf(d.y)};
                        const f32x2 hh = (a * b) * (r * rs2);
                        h[4 * n + 2 * p] = hh.x; h[4 * n + 2 * p + 1] = hh.y;
                    }
                *(gu32x4*)(H + (size_t)row * FF + col0) = pack8(h);
            }
    }
};
struct EpiRes {
    static constexpr bool PERM = true, AFTER_DRAIN = false, KSCALE = false;
    gbf16* xb; gf32* ssq_out; float scale;
    __device__ __forceinline__ void operator()(const pg8::f32x4 (&acc)[2][2][4][2], const pg8::Unit& u, int wr, int wc, int fr, int fq) const {
        const int row0 = u.pm * 256 + wr * 64 + fr, col0 = u.pn * 256 + wc * 32 + 8 * fq;
#pragma unroll
        for (int ai = 0; ai < 2; ++ai) {
            pg8::u32x4 xh[4][2];
#pragma unroll
            for (int mm = 0; mm < 4; ++mm)
#pragma unroll
                for (int bj = 0; bj < 2; ++bj) {
                    const size_t off = (size_t)(row0 + ai * 128 + mm * 16) * D + col0 + bj * 128;
                    xh[mm][bj] = *(const gu32x4*)(xb + off);
                }
#pragma unroll
            for (int mm = 0; mm < 4; ++mm) {
                const int m = mm;
                const int row = row0 + ai * 128 + m * 16;
                float ss = 0.f;
#pragma unroll
                for (int bj = 0; bj < 2; ++bj) {
                    const size_t off = (size_t)row * D + col0 + bj * 128;
                    float h[8];
#pragma unroll
                    for (int q = 0; q < 4; ++q) {
                        h[2 * q] = bflo(xh[mm][bj][q]) + acc[ai][bj][m][q >> 1][2 * (q & 1)] * scale;
                        h[2 * q + 1] = bfhi(xh[mm][bj][q]) + acc[ai][bj][m][q >> 1][2 * (q & 1) + 1] * scale;
                    }
                    const pg8::u32x4 hn = pack8(h);
                    *(gu32x4*)(xb + off) = hn;
                    ss += ((h[0] * h[0] + h[1] * h[1]) + (h[2] * h[2] + h[3] * h[3])) + ((h[4] * h[4] + h[5] * h[5]) + (h[6] * h[6] + h[7] * h[7]));
                }
                ss += __shfl_xor(ss, 16); ss += __shfl_xor(ss, 32);
                if (fq == 0) ssq_out[(size_t)row * SSQ_SLOTS + u.pn * 4 + wc] = ss;
            }
            asm volatile("" ::: "memory");
        }
    }
};
struct EpiResKS : EpiRes {
    static constexpr bool KSCALE = true;
    LAS unsigned char* lfac;
    __device__ __forceinline__ void kscale(pg8::f32x4 (&acc)[2][2][4][2], const pg8::Unit& u, int hb, int wr, int fr) const {
        int fr_ = fr; asm volatile("" : "+v"(fr_));
        const int lrow0 = wr * 64 + fr_;
#pragma unroll
        for (int ai = 0; ai < 2; ++ai)
#pragma unroll
            for (int m = 0; m < 4; ++m) {
                const float s = *(const LAS float*)(lfac + ((lrow0 + ai * 128 + m * 16) * 4 + hb - 1) * 4);
#pragma unroll
                for (int bj = 0; bj < 2; ++bj)
#pragma unroll
                    for (int n = 0; n < 2; ++n) acc[ai][bj][m][n] = acc[ai][bj][m][n] * s;
            }
    }
};
struct EpiRetIn {
    static constexpr bool PERM = true, AFTER_DRAIN = false, KSCALE = false;
    gbf16 *Q, *K, *V, *G; const LAS float* lrs; const gf32* rope; const gf32* gq; const gf32* gk;
    __device__ __forceinline__ void operator()(const pg8::f32x4 (&acc)[2][2][4][2], const pg8::Unit& u, int wr, int wc, int fr, int fq) const {
        const int row0 = u.pm * 256 + wr * 64 + fr, cl = wc * 32 + 8 * fq, pn = u.pn;
        if (pn < 8) {
            const bool isq = pn < 4; const int h = pn & 3; gbf16* dst = isq ? Q : K; const gf32* gt = (isq ? gq : gk) + h * 128; const float ksc = isq ? 1.0f : 0.0625f;
#pragma unroll
            for (int am = 0; am < 4; ++am) {
                const int ai = am >> 1;
                pg8::f32x4 cs[2][4]; float gv[2];
#pragma unroll
                for (int mm = 0; mm < 2; ++mm) {
                    const int row = row0 + ai * 128 + (2 * (am & 1) + mm) * 16;
                    const gf32x4* rp = (const gf32x4*)(rope + ((size_t)pos_index(row) * 128 + cl) * 2);
                    gv[mm] = gt[ret_tprime(row)];
#pragma unroll
                    for (int q = 0; q < 4; ++q) cs[mm][q] = rp[q];
                }
#pragma unroll
                for (int mm = 0; mm < 2; ++mm) {
                    const int m = 2 * (am & 1) + mm;
                    const int row = row0 + ai * 128 + m * 16;
                    const float dec = lrs[u.ord * 256 + (row - u.pm * 256)] * gv[mm] * ksc;
                    float o1[8], o2[8];
#pragma unroll
                    for (int n = 0; n < 2; ++n) {
                        const pg8::f32x4 cs0 = cs[mm][2 * n], cs1 = cs[mm][2 * n + 1];
                        const float c[4] = {cs0[0], cs0[2], cs1[0], cs1[2]}, s[4] = {cs0[1], cs0[3], cs1[1], cs1[3]};
#pragma unroll
                        for (int i = 0; i < 4; ++i) { const float x1 = acc[ai][0][m][n][i], x2 = acc[ai][1][m][n][i];
                            o1[4 * n + i] = (x1 * c[i] - x2 * s[i]) * dec; o2[4 * n + i] = (x1 * s[i] + x2 * c[i]) * dec; }
                    }
                    gbf16* p = dst + (size_t)row * R_QK + h * R_DK + cl;
                    *(gu32x4*)p = pack8(o1); *(gu32x4*)(p + 128) = pack8(o2);
                }
            }
        } else {
            const bool isv = pn < 16; gbf16* dst = isv ? V : G; const int cb = (isv ? pn - 8 : pn - 16) * 256 + cl;
#pragma unroll
            for (int ai = 0; ai < 2; ++ai)
#pragma unroll
                for (int m = 0; m < 4; ++m) {
                    const int row = row0 + ai * 128 + m * 16;
                    const float rs = lrs[u.ord * 256 + (row - u.pm * 256)];
#pragma unroll
                    for (int bj = 0; bj < 2; ++bj) {
                        float h[8];
#pragma unroll
                        for (int n = 0; n < 2; ++n)
#pragma unroll
                            for (int i = 0; i < 4; ++i) { const float v = acc[ai][bj][m][n][i] * rs; h[4 * n + i] = isv ? v : fast_silu(v); }
                        *(gu32x4*)(dst + (size_t)row * R_V + cb + bj * 128) = pack8(h);
                    }
                }
        }
    }
};
template <int SH> __device__ __forceinline__ float dpp_row_shr_one(float v) { return __builtin_bit_cast(float, __builtin_amdgcn_update_dpp(0x3f800000, __builtin_bit_cast(int, v), 0x110 + SH, 0xf, 0xf, false)); }
template <int SH> __device__ __forceinline__ float dpp_row_shr(float v) { return __builtin_bit_cast(float, __builtin_amdgcn_update_dpp(0, __builtin_bit_cast(int, v), 0x110 + SH, 0xf, 0xf, false)); }
struct EpiHgIn {
    static constexpr bool PERM = true, AFTER_DRAIN = false, KSCALE = false;
    gbf16 *Qb, *Kt, *V, *G; gf32* EB; const LAS float* lrs; const gf32* lb;
    template <bool SAMP>
    __device__ __forceinline__ void qz_tile(const pg8::f32x4 (&acc)[2][2][4][2], const pg8::Unit& u, int row0, int cl, int fr, int pn) const {
            const int cb = pn * 128 + cl; constexpr bool samp = SAMP; const int fl = samp ? (fr & 3) : fr, flast = samp ? 3 : 15;
            float lbv[8];
#pragma unroll
            for (int j = 0; j < 8; ++j) lbv[j] = lb[cb + j];
#pragma unroll
            for (int ai = 0; ai < 2; ++ai)
#pragma unroll
                for (int m = 0; m < 4; ++m) {
                    const int row = row0 + ai * 128 + m * 16;
                    const float rs = lrs[u.ord * 256 + (row - u.pm * 256)];
                    float qo[8], ko[8], eb[8];
#pragma unroll
                    for (int n = 0; n < 2; ++n)
#pragma unroll
                        for (int i = 0; i < 4; ++i) {
                            const int j = 4 * n + i;
                            const float qv = acc[ai][0][m][n][i] * rs, zv = acc[ai][1][m][n][i] * rs;
                            const float ez = __expf(-zv), s = __builtin_amdgcn_rcpf(1.0f + ez), sm = ez * s;
                            const float oml = 1.0f - lbv[j];
                            const float f = lbv[j] + oml * s, kk = oml * sm;
                            float e = f, t;
                            if constexpr (!SAMP) {
                                e *= dpp_row_shr_one<1>(e); e *= dpp_row_shr_one<2>(e); e *= dpp_row_shr_one<4>(e); e *= dpp_row_shr_one<8>(e);
                            } else {
                                t = dpp_row_shr<1>(e); e *= fl >= 1 ? t : 1.f;
                                t = dpp_row_shr<2>(e); e *= fl >= 2 ? t : 1.f;
                            }
                            qo[j] = fast_silu(qv) * e; ko[j] = kk * __builtin_amdgcn_rcpf(e); eb[j] = e;
                        }
                    *(gu32x4*)(Qb + (size_t)row * D + cb) = pack8(qo);
                    *(gu32x4*)(Kt + (size_t)row * D + cb) = pack8(ko);
                    if (fl == flast) { const int chunk = samp ? 1024 + ((row - MP) >> 2) : (row >> 4); gf32* ep = EB + (size_t)chunk * D + cb;
                        *(gf32x4*)ep = (pg8::f32x4){eb[0], eb[1], eb[2], eb[3]}; *(gf32x4*)(ep + 4) = (pg8::f32x4){eb[4], eb[5], eb[6], eb[7]}; }
                }
    }
    __device__ __forceinline__ void operator()(const pg8::f32x4 (&acc)[2][2][4][2], const pg8::Unit& u, int wr, int wc, int fr, int fq) const {
        const int row0 = u.pm * 256 + wr * 64 + fr, cl = wc * 32 + 8 * fq, pn = u.pn;
        if (pn < 8) {
            if (u.pm >= MP / 256) qz_tile<true>(acc, u, row0, cl, fr, pn); else qz_tile<false>(acc, u, row0, cl, fr, pn);
        } else {
            const bool isv = pn < 12; gbf16* dst = isv ? V : G; const int cb = (isv ? pn - 8 : pn - 12) * 256 + cl;
#pragma unroll
            for (int ai = 0; ai < 2; ++ai)
#pragma unroll
                for (int m = 0; m < 4; ++m) {
                    const int row = row0 + ai * 128 + m * 16;
                    const float rs = lrs[u.ord * 256 + (row - u.pm * 256)];
#pragma unroll
                    for (int bj = 0; bj < 2; ++bj) {
                        float h[8];
#pragma unroll
                        for (int n = 0; n < 2; ++n)
#pragma unroll
                            for (int i = 0; i < 4; ++i) { const float v = acc[ai][bj][m][n][i] * rs; h[4 * n + i] = isv ? v : fast_silu(v); }
                        *(gu32x4*)(dst + (size_t)row * D + cb + bj * 128) = pack8(h);
                    }
                }
        }
    }
};

struct Frame {
    LAS unsigned char* lds;
    volatile LAS unsigned* MISC;
    gu32* ctl;
    int tid, lane, wave, G;
};

__device__ __forceinline__ void transpose_item(const gf32* W, int N, const gf32* kscale, gbf16* WT, int K, int k0, int n0, int dst_row0, LAS float* scr, int lane) {
    float wv[32];
#pragma unroll
    for (int i = 0; i < 32; ++i) wv[i] = W[(size_t)(k0 + 2 * i + (lane >> 5)) * N + n0 + (lane & 31)];
#pragma unroll
    for (int i = 0; i < 32; ++i) { const int kk = 2 * i + (lane >> 5); const float sc = kscale ? kscale[k0 + kk] : 1.0f; scr[kk * 33 + (lane & 31)] = wv[i] * sc; }
    LDS_WAIT(); asm volatile("" ::: "memory");
    const int c = lane & 7;
#pragma unroll
    for (int j = 0; j < 4; ++j) { const int n = (lane >> 3) + 8 * j; const LAS float* s = scr + (8 * c) * 33 + n;
        v4u o; o.x = pk2(s[0 * 33], s[1 * 33]); o.y = pk2(s[2 * 33], s[3 * 33]); o.z = pk2(s[4 * 33], s[5 * 33]); o.w = pk2(s[6 * 33], s[7 * 33]);
        *(GAS v4u*)(WT + (size_t)(dst_row0 + n) * K + k0 + 8 * c) = o; }
    LDS_WAIT(); asm volatile("" ::: "memory");
}
__device__ __forceinline__ int pair_row(int c, int half_cols) {
    return c < half_cols ? 256 * (c >> 7) + (c & 127) : 256 * ((c - half_cols) >> 7) + 128 + ((c - half_cols) & 127);
}
__device__ __forceinline__ double dpow_int(double base, int e) { double r = 1.0, b = base; while (e > 0) { if (e & 1) r *= b; b *= b; e >>= 1; } return r; }
__device__ __forceinline__ void sincos_reduced(double ang, float& c, float& s) {
    const double k = __builtin_rint(ang * 0.6366197723675814);
    double y = __builtin_fma(-k, 1.5707963267948966, ang); y = __builtin_fma(-k, 6.123233995736766e-17, y);
    const double y2 = y * y;
    double sp = -1.0 / 39916800.0; sp = sp * y2 + 1.0 / 362880.0; sp = sp * y2 - 1.0 / 5040.0; sp = sp * y2 + 1.0 / 120.0; sp = sp * y2 - 1.0 / 6.0; sp = sp * y2 * y + y;
    double cp = 1.0 / 479001600.0; cp = cp * y2 - 1.0 / 3628800.0; cp = cp * y2 + 1.0 / 40320.0; cp = cp * y2 - 1.0 / 720.0; cp = cp * y2 + 1.0 / 24.0; cp = cp * y2 - 0.5; cp = cp * y2 + 1.0;
    const int q = ((int)k) & 3;
    const double cc = (q == 0) ? cp : (q == 1) ? -sp : (q == 2) ? -cp : sp;
    const double ssn = (q == 0) ? sp : (q == 1) ? cp : (q == 2) ? -sp : -cp;
    c = (float)cc; s = (float)ssn;
}
struct PrologueArgs { const gf32 *xp, *xs, *norm_gain, *w_up, *w_down, *ret_w_in, *ret_norm, *ret_w_out, *hg_w_in, *hg_lb, *hg_norm, *hg_w_out; GAS unsigned char* ws; };

__device__ __forceinline__ void convert_layer_weights(Frame& F, const PrologueArgs& A, int layer, int q0, int q1, int wid, int nw) {
    LAS float* scr = (LAS float*)(F.lds + RING_OFF + F.wave * 16384);
    GAS unsigned char* ws = A.ws;
    constexpr int I_UP = 16 * 176, I_DN = 44 * 32, I_RIN = 16 * 192, I_ROUT = 32 * 32, I_HIN = 16 * 128, I_HOUT = 16 * 32;
    const bool isret = (layer & 1) == 0; const int j = layer >> 1;
    const int NL = 2 * I_UP + 2 * I_DN + (isret ? I_RIN + I_ROUT : I_HIN + I_HOUT);
    const int lo = (int)((long)NL * q0 / 4), hi = (int)((long)NL * q1 / 4);
    for (int it = lo + wid; it < hi; it += nw) {
        int r = it;
        if (r < 2 * I_UP) { const int f = r / I_UP; r -= f * I_UP; const int idx = 2 * layer + f, kb = r / 176, nb = r % 176;
            transpose_item(A.w_up + (size_t)idx * D * NUP, NUP, A.norm_gain + (layer * 3 + (f ? 2 : 0)) * D, (gbf16*)(ws + WS_W + idx * W_FFN_STRIDE), D, 64 * kb, 32 * nb, pair_row(32 * nb, FF), scr, F.lane); continue; }
        r -= 2 * I_UP;
        if (r < 2 * I_DN) { const int f = r / I_DN; r -= f * I_DN; const int idx = 2 * layer + f, kb = r / 32, nb = r % 32;
            transpose_item(A.w_down + (size_t)idx * FF * D, D, nullptr, (gbf16*)(ws + WS_W + idx * W_FFN_STRIDE + W_DOWN_OFF), FF, 64 * kb, 32 * nb, 32 * nb, scr, F.lane); continue; }
        r -= 2 * I_DN;
        if (isret) {
            if (r < I_RIN) { const int kb = r / 192, nb = r % 192;
                transpose_item(A.ret_w_in + (size_t)j * D * R_NIN, R_NIN, A.norm_gain + (layer * 3 + 1) * D, (gbf16*)(ws + WS_W + W_RET_BASE + j * W_RET_STRIDE), D, 64 * kb, 32 * nb, 32 * nb, scr, F.lane); continue; }
            r -= I_RIN;
            { const int kb = r / 32, nb = r % 32;
                transpose_item(A.ret_w_out + (size_t)j * R_V * D, D, A.ret_norm + j * R_V, (gbf16*)(ws + WS_W + W_RET_BASE + j * W_RET_STRIDE + W_ROUT_OFF), R_V, 64 * kb, 32 * nb, 32 * nb, scr, F.lane); }
        } else {
            if (r < I_HIN) { const int kb = r / 128, nb = r % 128; const int n0 = 32 * nb;
                transpose_item(A.hg_w_in + (size_t)j * D * G_NIN, G_NIN, A.norm_gain + (layer * 3 + 1) * D, (gbf16*)(ws + WS_W + W_HG_BASE + j * W_HG_STRIDE), D, 64 * kb, n0, n0 < 2048 ? pair_row(n0, 1024) : n0, scr, F.lane); continue; }
            r -= I_HIN;
            { const int kb = r / 32, nb = r % 32;
                transpose_item(A.hg_w_out + (size_t)j * D * D, D, A.hg_norm + j * D, (gbf16*)(ws + WS_W + W_HG_BASE + j * W_HG_STRIDE + W_HOUT_OFF), D, 64 * kb, 32 * nb, 32 * nb, scr, F.lane); }
        }
    }
}
__device__ __forceinline__ void p0_prologue(Frame& F, const PrologueArgs& A) {
    LAS float* scr = (LAS float*)(F.lds + RING_OFF + F.wave * 16384);
    const int gw = blockIdx.x * NWAVES + F.wave, NGW = F.G * NWAVES;
    GAS unsigned char* ws = A.ws;
    {
        gbf16* XB = (gbf16*)(ws + WS_XB); gf32* ssq0 = (gf32*)(ws + WS_SSQ);
        for (int row = gw; row < M; row += NGW) {
            const gf32* src = row < MP ? A.xp + (size_t)row * D : A.xs + (size_t)(row - MP) * D;
            const GAS f32x4* xr = (const GAS f32x4*)src + F.lane;
            f32x4 v[4]; float s = 0.f;
#pragma unroll
            for (int j = 0; j < 4; ++j) { v[j] = xr[64 * j]; s += (v[j].x * v[j].x + v[j].y * v[j].y) + (v[j].z * v[j].z + v[j].w * v[j].w); }
            s = wave_sum(s);
            GAS v2u* bo = (GAS v2u*)(XB + (size_t)row * D) + F.lane;
#pragma unroll
            for (int j = 0; j < 4; ++j) { v2u w; w.x = pk2(v[j].x, v[j].y); w.y = pk2(v[j].z, v[j].w); bo[64 * j] = w; }
            if (F.lane < SSQ_SLOTS) ssq0[(size_t)row * SSQ_SLOTS + F.lane] = F.lane == 0 ? s : 0.f;
        }
    }
    {
        const int gt = blockIdx.x * (NWAVES * 64) + F.tid, NT = F.G * NWAVES * 64;
        gf32* rope = (gf32*)(ws + WS_ROPE); gf32* tab2 = (gf32*)(ws + WS_TAB2);
        for (int i = gt; i < (TP + TS) * 128; i += NT) {
            const int p = i >> 7, j = i & 127; const double pos = p < TP ? (double)p : (double)(16384 + (p - TP));
            const double inv = dpow_int(0.9305720409296989792906463, j);
            float c, s; sincos_reduced(pos * inv, c, s); rope[2 * i] = c; rope[2 * i + 1] = s;
        }
        for (int i = gt; i < 4 * 128; i += NT) {
            const int h = i >> 7, t = i & 127; const double gam = 1.0 - dpow_int(0.5, 5 + h), g = dpow_int(gam, t + 1);
            tab2[i] = (float)g; tab2[512 + i] = (float)(1.0 / g);
        }
        for (int i = gt; i < 8; i += NT) { const int h = i >> 1; const double gam = 1.0 - dpow_int(0.5, 5 + h); tab2[1024 + i] = (float)dpow_int(gam, (i & 1) ? 4 : R_C); }
        for (int i = gt; i < 2048; i += NT) { const int c = i & 1023; tab2[2048 + i] = (i < 1024) ? 0.0f : 1.0f / (1.0f + expf(A.hg_lb[c] - A.hg_lb[1024 + c])); }
    }
    convert_layer_weights(F, A, 0, 0, 4, gw, NGW);
}

template <int DK, int DV, int H, int CP>
__device__ __forceinline__ void rec_naive(Frame& F, const gbf16* Qh, const gbf16* Kt, const gbf16* V, const gf32* EB, const gf32* gC, const gf32* S0, gbf16* O  , gf32* SoutP, gf32* SoutS, int u0  , int bofs  ,
                                          const gbf16* Gt = nullptr  , gbf16* OBg = nullptr, gf32* SSQo = nullptr) {
    constexpr int EG = DV / 64, RD = DK / 8, NU = (NSEQ_P + NSEQ_S) * H * EG;
    LAS float* red = (LAS float*)(F.lds + RING_OFF);
    int vz; asm volatile("v_mov_b32 %0, 0" : "=v"(vz));
    if ((int)blockIdx.x >= bofs)
    for (int u = u0 + (int)blockIdx.x - bofs; u < NU; u += F.G - bofs) {
        const int seq = u / (H * EG), h = (u / EG) % H, eg = u % EG;
        const bool samp = seq >= NSEQ_P;
        const int T = samp ? TS : TP, C = samp ? 4 : CP;
        const int rowb = samp ? MP + (seq - NSEQ_P) * TS : seq * TP;
        const int d0 = F.wave * RD, e = eg * 64 + F.lane;
        float R[RD];
        if (samp) { const gf32* s0 = S0 + (((size_t)(seq - NSEQ_P) * H + h) * DK + d0) * DV + e;
#pragma unroll
            for (int i = 0; i < RD; ++i) R[i] = s0[(size_t)i * DV]; }
        else {
#pragma unroll
            for (int i = 0; i < RD; ++i) R[i] = 0.f; }
        const float gsc = gC ? gC[h * 2 + (samp ? 1 : 0)] : 1.0f;
        v4u kn[RD / 8], qn[RD / 8]; unsigned short vn;
        { const size_t ro = (size_t)rowb * (H * DK) + h * DK + d0 + vz;
#pragma unroll
          for (int c8 = 0; c8 < RD / 8; ++c8) { kn[c8] = ((const gv4u*)(Kt + ro))[c8]; qn[c8] = ((const gv4u*)(Qh + ro))[c8]; }
          vn = V[(size_t)rowb * (H * DV) + h * DV + e]; }
        for (int t0 = 0; t0 < T; t0 += 4) {
            const int buf = (t0 >> 2) & 1;
#pragma unroll 1
            for (int tt = 0; tt < 4; ++tt) {
                const int row = rowb + t0 + tt;
                v4u kc[RD / 8], qc[RD / 8];
#pragma unroll
                for (int c8 = 0; c8 < RD / 8; ++c8) { kc[c8] = kn[c8]; qc[c8] = qn[c8]; }
                const float v = bf2f(vn);
                { const int rown = (t0 + tt + 1 < T) ? row + 1 : row;
                  const size_t ro = (size_t)rown * (H * DK) + h * DK + d0 + vz;
#pragma unroll
                  for (int c8 = 0; c8 < RD / 8; ++c8) { kn[c8] = ((const gv4u*)(Kt + ro))[c8]; qn[c8] = ((const gv4u*)(Qh + ro))[c8]; }
                  vn = V[(size_t)rown * (H * DV) + h * DV + e]; }
                float p = 0.f;
#pragma unroll
                for (int c8 = 0; c8 < RD / 8; ++c8) {
                    const unsigned kk[4] = {kc[c8].x, kc[c8].y, kc[c8].z, kc[c8].w}, qq[4] = {qc[c8].x, qc[c8].y, qc[c8].z, qc[c8].w};
#pragma unroll
                    for (int w2 = 0; w2 < 4; ++w2) {
                        R[c8 * 8 + 2 * w2] += bflo(kk[w2]) * v; p += bflo(qq[w2]) * R[c8 * 8 + 2 * w2];
                        R[c8 * 8 + 2 * w2 + 1] += bfhi(kk[w2]) * v; p += bfhi(qq[w2]) * R[c8 * 8 + 2 * w2 + 1];
                    }
                }
                red[((buf * 4 + tt) * 8 + F.wave) * 64 + F.lane] = p;
                if (((t0 + tt + 1) % C) == 0) {
                    if (EB) { const int chunk = samp ? 1024 + ((row - MP) >> 2) : (row >> 4); const gf32* ep = EB + (size_t)chunk * (H * DK) + h * DK + d0 + vz;
#pragma unroll
                        for (int i = 0; i < RD; ++i) R[i] *= ep[i]; }
                    else {
#pragma unroll
                        for (int i = 0; i < RD; ++i) R[i] *= gsc; }
                }
            }
            LDS_WAIT(); __syncthreads();
            if (F.tid < 256) { const int tt = F.tid >> 6, l = F.tid & 63; float s = 0.f;
#pragma unroll
                for (int w = 0; w < 8; ++w) s += red[((buf * 4 + tt) * 8 + w) * 64 + l];
                const size_t oi = (size_t)(rowb + t0 + tt) * (H * DV) + h * DV + eg * 64 + l;
                if (Gt) { OBg[oi] = (bf16)f2bf(s * bf2f(Gt[oi])); const float ss = wave_sum(s * s); if (l == 0) SSQo[(size_t)(rowb + t0 + tt) * (H * EG) + h * EG + eg] = ss; }
                else O[oi] = (bf16)f2bf(s); }
        }
        gf32* so = samp ? SoutS + (((size_t)(seq - NSEQ_P) * H + h) * DK + d0) * DV + e : SoutP + (((size_t)seq * H + h) * DK + d0) * DV + e;
#pragma unroll
        for (int i = 0; i < RD; ++i) so[(size_t)i * DV] = R[i];
        LDS_WAIT(); __syncthreads();
    }
}

template <int DV>
__device__ __forceinline__ void headnorm_phase(Frame& F, const gbf16* O, const gbf16* Gt, gbf16* OB, int ntask  ) {
    constexpr int LPH = DV / 8;
    const int gw = blockIdx.x * NWAVES + F.wave, NGW = F.G * NWAVES;
    for (int t = gw; t < ntask; t += NGW) {
        const size_t base = (size_t)t * 512 + F.lane * 8;
        const v4u o8 = *(const gv4u*)(O + base);
        const f32x4 a = (f32x4){bflo(o8.x), bfhi(o8.x), bflo(o8.y), bfhi(o8.y)}, b = (f32x4){bflo(o8.z), bfhi(o8.z), bflo(o8.w), bfhi(o8.w)};
        const v4u g = *(const gv4u*)(Gt + base);
        float ss = (a.x * a.x + a.y * a.y) + (a.z * a.z + a.w * a.w) + (b.x * b.x + b.y * b.y) + (b.z * b.z + b.w * b.w);
#pragma unroll
        for (int o = 1; o < LPH; o <<= 1) ss += __shfl_xor(ss, o);
        const float rs = rsqrtf(ss * (1.0f / DV) + EPS);
        v4u w; w.x = pk2(a.x * rs * bflo(g.x), a.y * rs * bfhi(g.x)); w.y = pk2(a.z * rs * bflo(g.y), a.w * rs * bfhi(g.y));
        w.z = pk2(b.x * rs * bflo(g.z), b.y * rs * bfhi(g.z)); w.w = pk2(b.z * rs * bflo(g.w), b.w * rs * bfhi(g.w));
        *(gv4u*)(OB + base) = w;
    }
}
__device__ __forceinline__ float ret_head_rstd(const gf32* SSQo, int row, int h) {
    const GAS f32x4* p = (const GAS f32x4*)(SSQo + (size_t)row * 64 + h * 16); const f32x4 a = p[0], b = p[1], c4 = p[2], d4 = p[3];
    const float s = (((a.x + a.y) + (a.z + a.w)) + ((b.x + b.y) + (b.z + b.w))) + (((c4.x + c4.y) + (c4.z + c4.w)) + ((d4.x + d4.y) + (d4.z + d4.w)));
    return rsqrtf(s * (1.0f / R_DV) + EPS);
}
__device__ __forceinline__ void ret_rstd_phase(Frame& F, const gf32* SSQo, gf32* RT8) {
    for (int row = blockIdx.x * (NWAVES * 64) + F.tid; row < M; row += F.G * NWAVES * 64) {
        float r[4];
#pragma unroll
        for (int h = 0; h < 4; ++h) {
            const GAS f32x4* p = (const GAS f32x4*)(SSQo + (size_t)row * 64 + h * 16); const f32x4 a = p[0], b = p[1], c4 = p[2], d4 = p[3];
            const float s = (((a.x + a.y) + (a.z + a.w)) + ((b.x + b.y) + (b.z + b.w))) + (((c4.x + c4.y) + (c4.z + c4.w)) + ((d4.x + d4.y) + (d4.z + d4.w)));
            r[h] = rsqrtf(s * (1.0f / R_DV) + EPS);
        }
        *(GAS f32x4*)(RT8 + (size_t)row * 8) = (f32x4){r[0], r[1], r[2], r[3]};
        *(GAS f32x4*)(RT8 + (size_t)row * 8 + 4) = (f32x4){r[0] / r[1], r[1] / r[2], r[2] / r[3], r[3]};
    }
}
__device__ __forceinline__ void final_phase(Frame& F, const gbf16* XB, const gf32* ssq, const gf32* fn, gf32* out, float probe_scale  ) {
    const int gw = blockIdx.x * NWAVES + F.wave, NGW = F.G * NWAVES;
    for (int row = gw; row < M; row += NGW) {
        const float rs = row_rstd(ssq, row) * (row >= MP ? probe_scale : 1.0f);
        const GAS v2u* hr = (const GAS v2u*)(XB + (size_t)row * D) + F.lane;
        const GAS f32x4* gr = (const GAS f32x4*)fn + F.lane; GAS f32x4* yo = (GAS f32x4*)(out + (size_t)row * D) + F.lane;
#pragma unroll
        for (int j = 0; j < 4; ++j) { const v2u hh = hr[64 * j]; const f32x4 g = gr[64 * j];
            const f32x4 v = (f32x4){bflo(hh.x), bfhi(hh.x), bflo(hh.y), bfhi(hh.y)};
            yo[64 * j] = (f32x4){v.x * rs * g.x, v.y * rs * g.y, v.z * rs * g.z, v.w * rs * g.w}; }
    }
}

typedef float f32x16 __attribute__((ext_vector_type(16)));
typedef short s16x4 __attribute__((ext_vector_type(4)));
typedef short s16x8 __attribute__((ext_vector_type(8)));
typedef __bf16 bf16x2_t __attribute__((ext_vector_type(2)));
typedef float f32x2_t __attribute__((ext_vector_type(2)));
__device__ __forceinline__ unsigned pkbf(float lo, float hi) { const f32x2_t v = {lo, hi}; return __builtin_bit_cast(unsigned, __builtin_convertvector(v, bf16x2_t)); }
#define MFMA32(a, b, c) __builtin_amdgcn_mfma_f32_32x32x16_bf16((a), (b), (c), 0, 0, 0)
__device__ __forceinline__ int swz16(int row) { return ((row & 3) << 2) | ((row >> 2) & 3); }
__device__ __forceinline__ s16x8 tr_pair(LAS unsigned char* p0, LAS unsigned char* p1) {
    const s16x4 lo = __builtin_amdgcn_ds_read_tr16_b64_v4i16((LAS s16x4*)p0), hi = __builtin_amdgcn_ds_read_tr16_b64_v4i16((LAS s16x4*)p1);
    return __builtin_shufflevector(lo, hi, 0, 1, 2, 3, 4, 5, 6, 7);
}
__device__ __forceinline__ void glds16_asm(const GAS void* gsrc, unsigned lds_dst) {
    unsigned keep;
    asm volatile("s_mov_b32 %0, m0\n\ts_mov_b32 m0, %2\n\ts_nop 0\n\tglobal_load_lds_dwordx4 %1, off\n\ts_mov_b32 m0, %0" : "=&s"(keep) : "v"(gsrc), "s"(lds_dst) : "memory");
}
constexpr int RF_KT = 0, RF_VT = 65536, RF_RT = 81920, RF_OX = 114688;
static_assert(RF_OX + 32768 <= RING_BYTES, "retention LDS map");

#ifndef PROBE_BLK
#define PROBE_BLK 0
#define PROBE_WAVE 0
#endif
__device__ __forceinline__ void ret_fast(Frame& F, const gbf16* Qh, const gbf16* Kt, const gbf16* V, const gf32* gC, const gbf16* Gt, gbf16* OBg, gf32* SSQo, gf32* SoutP, GAS void* probe_out) {
    LAS unsigned char* L = F.lds + RING_OFF;
    const unsigned Lb = (unsigned)(size_t)L;
    const int wave = F.wave;
    const int kh = wave >> 2, tt = ((wave >> 1) ^ (wave >> 2)) & 1, et = wave & 1;
    const int nown = tt == 0 ? 3 : 1, dtb = tt == 0 ? 3 * kh : 6 + kh;
    constexpr int NCH = TP / R_C;
    for (int u = blockIdx.x; u < NSEQ_P * R_H * 8; u += F.G) {
        const int pair = (u & 7) * 4 + ((u >> 3) >> 3), sl = (u >> 3) & 7;
        const int b = pair >> 2, h = pair & 3;
        const int rowb = b * TP;
        const float gsc = gC[h * 2];
        int lane0 = F.lane; asm volatile("" : "+v"(lane0));
        f32x16 racc[3];
#pragma unroll
        for (int i = 0; i < 3; ++i)
#pragma unroll
            for (int r = 0; r < 16; ++r) racc[i][r] = 0.f;
        for (int i = F.tid; i < 32768 / 16; i += NWAVES * 64) *(LAS v4u*)(L + RF_RT + i * 16) = (v4u){0u, 0u, 0u, 0u};
#define RF_DMA(c_) do { const int cr0_ = rowb + (c_) * R_C; const unsigned kb_ = Lb + RF_KT + ((c_) & 1) * 32768 + 8 * wave * 512, vb_ = Lb + RF_VT + ((c_) & 1) * 8192 + 8 * wave * 128; \
            _Pragma("unroll") for (int i_ = 0; i_ < 4; ++i_) { const int row_ = 8 * wave + 2 * i_ + (lane >> 5), ch_ = (lane & 31) ^ swz16(row_); \
                glds16_asm((const GAS void*)(Kt + (size_t)(cr0_ + row_) * R_QK + h * R_DK + 8 * ch_), __builtin_amdgcn_readfirstlane(kb_ + i_ * 1024)); } \
            { const int row_ = 8 * wave + (lane >> 3), ch_ = (lane & 7) ^ (((row_ >> 1) & 1) << 2); \
              glds16_asm((const GAS void*)(V + (size_t)(cr0_ + row_) * R_V + h * R_DV + sl * 64 + 8 * ch_), __builtin_amdgcn_readfirstlane(vb_)); } } while (0)
#if defined(PROBE_SEC) && PROBE_SEC >= 10
        unsigned long long rprobe_acc = 0;
#endif
        s16x8 qf[8];
#define RF_LOADQ(c_) do { const gbf16* qptr_ = Qh + (size_t)(rowb + (c_) * R_C + 32 * tt + (lane & 31)) * R_QK + h * R_DK + 128 * kh + 8 * (lane >> 5); \
            _Pragma("unroll") for (int ks_ = 0; ks_ < 8; ++ks_) qf[ks_] = *(const GAS s16x8*)(qptr_ + 16 * ks_); } while (0)
        { const int lane = lane0; RF_DMA(0); RF_LOADQ(0); }
        __builtin_amdgcn_s_waitcnt(0x0070);
        for (int c = 0; c < NCH; ++c) {
            const int crow0 = rowb + c * R_C;
            int lane = F.lane; asm volatile("" : "+v"(lane));
            const int l31 = lane & 31, hh = lane >> 5, i16 = lane & 15, q4 = i16 >> 2, p4 = i16 & 3, gb = (lane >> 4) & 1;
            const int erow = 32 * et + l31, esw = swz16(erow), ksw = swz16(l31);
            LAS unsigned char* KTb = L + RF_KT + (c & 1) * 32768;
            LAS unsigned char* VTb = L + RF_VT + (c & 1) * 8192;
#if defined(PROBE_SEC) && PROBE_SEC >= 10
            const unsigned long long rp0 = __builtin_amdgcn_s_memtime();
#endif
            __builtin_amdgcn_s_waitcnt(0x0072);
            __builtin_amdgcn_s_barrier(); asm volatile("" ::: "memory");
#if defined(PROBE_SEC) && PROBE_SEC >= 10
            const unsigned long long rp1 = __builtin_amdgcn_s_memtime();
#endif
            if (c + 1 < NCH) RF_DMA(c + 1);
#if defined(PROBE_SEC) && PROBE_SEC >= 10
            const unsigned long long rp2 = __builtin_amdgcn_s_memtime();
#endif
            f32x16 oacc;
#pragma unroll
            for (int r = 0; r < 16; ++r) oacc[r] = 0.f;
#pragma unroll
            for (int ks = 0; ks < 8; ++ks) {
                const s16x8 rf = *(const LAS s16x8*)(L + RF_RT + erow * 512 + 16 * ((2 * (8 * kh + ks) + hh) ^ esw));
                oacc = MFMA32(qf[ks], rf, oacc);
            }
#if defined(PROBE_SEC) && PROBE_SEC >= 10
            asm volatile("s_nop 0" :: "v"(oacc[0]), "v"(oacc[15]));
            const unsigned long long rp3 = __builtin_amdgcn_s_memtime();
#endif
            LAS unsigned char* vbase = VTb + (4 * hh + q4) * 128 + 16 * ((4 * et + 2 * gb + (p4 >> 1)) ^ (((q4 >> 1) & 1) << 2)) + 8 * (p4 & 1);
#pragma unroll 1
            for (int st = 0; st <= tt; ++st) {
                f32x16 X;
#pragma unroll
                for (int r = 0; r < 16; ++r) X[r] = 0.f;
                LAS unsigned char* kb_ = KTb + (32 * st + l31) * 512;
#pragma unroll
                for (int ks = 0; ks < 8; ++ks) { const s16x8 kf = *(const LAS s16x8*)(kb_ + 16 * ((2 * (8 * kh + ks) + hh) ^ ksw)); X = MFMA32(kf, qf[ks], X); }
                if (st == tt) {
#pragma unroll
                    for (int r = 0; r < 16; ++r) { const int sl_ = (r & 3) + 8 * (r >> 2) + 4 * hh; X[r] = sl_ <= l31 ? X[r] : 0.f; }
                }
#pragma unroll
                for (int s2 = 0; s2 < 2; ++s2) {
                    LAS unsigned char* vp = vbase + (2 * st + s2) * 2048;
                    const s16x8 vf = tr_pair(vp, vp + 1024);
                    v4u pk; pk.x = pkbf(X[8 * s2 + 0], X[8 * s2 + 1]); pk.y = pkbf(X[8 * s2 + 2], X[8 * s2 + 3]); pk.z = pkbf(X[8 * s2 + 4], X[8 * s2 + 5]); pk.w = pkbf(X[8 * s2 + 6], X[8 * s2 + 7]);
                    oacc = MFMA32(__builtin_bit_cast(s16x8, pk), vf, oacc);
                }
            }
#if defined(PROBE_SEC) && PROBE_SEC >= 10
            asm volatile("s_nop 0" :: "v"(oacc[0]), "v"(oacc[15]));
            const unsigned long long rp4 = __builtin_amdgcn_s_memtime();
#endif
            if (c + 1 < NCH) RF_LOADQ(c + 1);
#if defined(PROBE_SEC) && PROBE_SEC >= 10
            const unsigned long long rp5 = __builtin_amdgcn_s_memtime();
#endif
            {
                LAS unsigned char* kt0 = KTb + (4 * hh + q4) * 512 + 8 * (p4 & 1);
                const int sw0 = (q4 << 2) | hh, sw1 = (q4 << 2) | ((hh + 2) & 3);
                const int cl = 2 * gb + (p4 >> 1);
                int o0[3], o1[3];
#pragma unroll
                for (int i = 0; i < 3; ++i) { o0[i] = 16 * ((4 * (dtb + i) + cl) ^ sw0); o1[i] = 16 * ((4 * (dtb + i) + cl) ^ sw1) + 8 * 512; }
#pragma unroll
                for (int k8 = 0; k8 < R_C / 16; ++k8) {
                    LAS unsigned char* vp = vbase + k8 * 2048;
                    const s16x8 vf = tr_pair(vp, vp + 1024);
                    { const s16x8 ka = tr_pair(kt0 + k8 * 8192 + o0[0], kt0 + k8 * 8192 + o1[0]); racc[0] = MFMA32(ka, vf, racc[0]); }
                    if (nown == 3) {
                        const s16x8 kb2 = tr_pair(kt0 + k8 * 8192 + o0[1], kt0 + k8 * 8192 + o1[1]); racc[1] = MFMA32(kb2, vf, racc[1]);
                        const s16x8 kc2 = tr_pair(kt0 + k8 * 8192 + o0[2], kt0 + k8 * 8192 + o1[2]); racc[2] = MFMA32(kc2, vf, racc[2]);
                    }
                }
            }
#pragma unroll
            for (int i = 0; i < 3; ++i)
#pragma unroll
                for (int r = 0; r < 16; ++r) racc[i][r] *= gsc;
#if defined(PROBE_SEC) && PROBE_SEC >= 10
            const unsigned long long rp6 = __builtin_amdgcn_s_memtime();
#endif
            {
                LAS float* ox = (LAS float*)(L + RF_OX + ((tt * 2 + et) * 2 + kh) * 4096) + (4 * hh) * 32 + l31;
#pragma unroll
                for (int r = 0; r < 16; ++r) ox[((r & 3) + 8 * (r >> 2)) * 32] = oacc[r];
            }
            asm volatile("s_waitcnt lgkmcnt(0)" ::: "memory"); __builtin_amdgcn_s_barrier(); asm volatile("" ::: "memory");
            {
                const int t = F.tid >> 3, cg = F.tid & 7;
                const LAS unsigned char* p0 = L + RF_OX + (((t >> 5) * 2 + (cg >> 2)) * 2) * 4096 + (t & 31) * 128 + (cg & 3) * 32;
                const pg8::f32x4 a0 = *(const LAS pg8::f32x4*)p0, a1 = *(const LAS pg8::f32x4*)(p0 + 16), b0 = *(const LAS pg8::f32x4*)(p0 + 4096), b1 = *(const LAS pg8::f32x4*)(p0 + 4096 + 16);
                const size_t oi = (size_t)(crow0 + t) * R_V + h * R_DV + sl * 64 + 8 * cg;
                const v4u g = *(const gv4u*)(Gt + oi);
                const pg8::f32x4 o0 = a0 + b0, o1 = a1 + b1;
                v4u w; w.x = pkbf(o0[0] * bflo(g.x), o0[1] * bfhi(g.x)); w.y = pkbf(o0[2] * bflo(g.y), o0[3] * bfhi(g.y)); w.z = pkbf(o1[0] * bflo(g.z), o1[1] * bfhi(g.z)); w.w = pkbf(o1[2] * bflo(g.w), o1[3] * bfhi(g.w));
                *(gv4u*)(OBg + oi) = w;
                float ss = ((o0[0] * o0[0] + o0[1] * o0[1]) + (o0[2] * o0[2] + o0[3] * o0[3])) + ((o1[0] * o1[0] + o1[1] * o1[1]) + (o1[2] * o1[2] + o1[3] * o1[3]));
                ss += __shfl_xor(ss, 1); ss += __shfl_xor(ss, 2); ss += __shfl_xor(ss, 4);
                if (cg == 0) SSQo[(size_t)(crow0 + t) * 32 + h * 8 + sl] = ss;
            }
            if (c + 1 < NCH) {
#pragma unroll
                for (int i = 0; i < 3; ++i)
                    if (i < nown) {
#pragma unroll
                        for (int g = 0; g < 4; ++g) {
                            v2u w; w.x = pkbf(racc[i][4 * g], racc[i][4 * g + 1]); w.y = pkbf(racc[i][4 * g + 2], racc[i][4 * g + 3]);
                            *(LAS v2u*)(L + RF_RT + erow * 512 + 16 * ((4 * (dtb + i) + g) ^ esw) + 8 * hh) = w;
                        }
                    }
            }
#if defined(PROBE_SEC) && PROBE_SEC >= 10
            { asm volatile("s_nop 0" :: "v"(racc[0][0]), "v"(racc[0][15]));
              const unsigned long long rp7 = __builtin_amdgcn_s_memtime();
              const unsigned long long d_ = PROBE_SEC == 10 ? rp1 - rp0 : PROBE_SEC == 11 ? rp2 - rp1 : PROBE_SEC == 12 ? rp3 - rp2 : PROBE_SEC == 13 ? rp4 - rp3 : PROBE_SEC == 14 ? rp5 - rp4 : PROBE_SEC == 15 ? rp6 - rp5 : PROBE_SEC == 16 ? rp7 - rp6 : rp7 - rp0;
              if (c >= 2) rprobe_acc += d_; }
#endif
        }
#if defined(PROBE_SEC) && PROBE_SEC >= 10
        if (blockIdx.x == PROBE_BLK && F.tid == PROBE_WAVE * 64) *(GAS unsigned long long*)probe_out = rprobe_acc / (NCH - 2);
#endif
#undef RF_DMA
#undef RF_LOADQ
        {
            const int l31 = lane0 & 31, hh = lane0 >> 5;
            gf32* sp = SoutP + ((size_t)(b * R_H + h) * R_DK + 4 * hh) * R_DV + sl * 64 + 32 * et + l31;
#pragma unroll
            for (int i = 0; i < 3; ++i)
                if (i < nown) {
#pragma unroll
                    for (int r = 0; r < 16; ++r) sp[(size_t)(32 * (dtb + i) + (r & 3) + 8 * (r >> 2)) * R_DV] = racc[i][r];
                }
        }
        asm volatile("s_waitcnt vmcnt(0) lgkmcnt(0)" ::: "memory"); __builtin_amdgcn_s_barrier(); asm volatile("" ::: "memory");
    }
}

#define MFMA16(a, b, c) __builtin_amdgcn_mfma_f32_16x16x32_bf16((a), (b), (c), 0, 0, 0)
constexpr int HF_KT = 0, HF_QT = 4096 + 64, HF_VT = 8192 + 128, HF_EB = 12288 + 192, HF_SLOT = 13568, HF_NSLOT = 4;
static_assert(HF_SLOT * HF_NSLOT <= RING_BYTES, "hgrn ring");
__device__ __forceinline__ void hg_fast(Frame& F, const gbf16* Qb, const gbf16* Kt, const gbf16* V, const gf32* EB, gbf16* O  , gf32* SoutP, GAS void* probe_out) {
    const int wave = F.wave;
    const unsigned Lb = (unsigned)(size_t)(F.lds + RING_OFF);
    LAS unsigned char* L = F.lds + RING_OFF;
    for (int u = blockIdx.x; u < NSEQ_P * G_H; u += F.G) {
        const int b = u >> 3, h = u & 7;
        int lane = F.lane; asm volatile("" : "+v"(lane));
        const int c16 = lane & 15, quad = lane >> 4;
        const size_t rowb = (size_t)b * TP;
        const int wl = wave & 3, prow = 4 * wl + quad, plc = 2 * ((c16 >> 1) ^ (prow & 7)) + ((c16 & 1) ^ (prow >> 3));
        const gbf16* srcA = (wave < 4 ? Kt : Qb) + (rowb + prow) * D + h * G_DK + 8 * plc;
        const gbf16* srcBv = V + (rowb + prow) * D + h * G_DV + 8 * plc;
        const gf32* srcBe = EB + (rowb >> 4) * D + h * G_DK + 4 * (lane & 31);
        const unsigned dstA = __builtin_amdgcn_readfirstlane(Lb + (wave < 4 ? HF_KT : HF_QT) + wl * 1024), dstB = __builtin_amdgcn_readfirstlane(Lb + (wave < 4 ? HF_VT + wl * 1024 : HF_EB));
#define HF_DMA(ci_) do { const int cc_ = (ci_) < TP / 16 ? (ci_) : TP / 16 - 1; const unsigned so_ = (unsigned)(((ci_) & (HF_NSLOT - 1)) * HF_SLOT); \
            glds16_asm((const GAS void*)(srcA + (size_t)cc_ * 16 * D), dstA + so_); \
            if (wave < 4) glds16_asm((const GAS void*)(srcBv + (size_t)cc_ * 16 * D), dstB + so_); else glds16_asm((const GAS void*)(srcBe + (size_t)cc_ * D), dstB + so_); } while (0)
        pg8::f32x4 R[8];
#pragma unroll
        for (int t = 0; t < 8; ++t) R[t] = (pg8::f32x4){0.f, 0.f, 0.f, 0.f};
#if defined(PROBE_SEC) && PROBE_SEC < 10
        unsigned long long probe_acc = 0;
#endif
        HF_DMA(0); HF_DMA(1);
        __builtin_amdgcn_s_waitcnt(0x0F70);
#pragma unroll 1
        for (int ci = 0; ci < TP / 16; ++ci) {
#if defined(PROBE_SEC) && PROBE_SEC < 10
            const unsigned long long tp0 = __builtin_amdgcn_s_memtime();
#endif
            if (ci < 2) asm volatile("s_waitcnt vmcnt(0)" ::: "memory"); else asm volatile("s_waitcnt vmcnt(10)" ::: "memory");
#if defined(PROBE_SEC) && PROBE_SEC < 10
            const unsigned long long tp1 = __builtin_amdgcn_s_memtime();
#endif
            __builtin_amdgcn_s_barrier(); asm volatile("" ::: "memory");
#if defined(PROBE_SEC) && PROBE_SEC < 10
            const unsigned long long tp2 = __builtin_amdgcn_s_memtime();
#endif
            HF_DMA(ci + 2);
            LAS unsigned char* sb = L + (ci & (HF_NSLOT - 1)) * HF_SLOT;
            v4u kf[4], qf[4]; v2u ktr[8];
#pragma unroll
            for (int kk = 0; kk < 4; ++kk) {
                const int qo = 16 * ((quad >> 1) ^ (c16 >> 3)) + 8 * (quad & 1);
                const int o0 = c16 * 256 + 32 * ((2 * kk) ^ (c16 & 7)) + qo, o1 = c16 * 256 + 32 * ((2 * kk + 1) ^ (c16 & 7)) + qo;
                const v2u ka = *(const LAS v2u*)(sb + HF_KT + o0), kb = *(const LAS v2u*)(sb + HF_KT + o1), qa = *(const LAS v2u*)(sb + HF_QT + o0), qb = *(const LAS v2u*)(sb + HF_QT + o1);
                kf[kk] = (v4u){ka.x, ka.y, kb.x, kb.y}; qf[kk] = (v4u){qa.x, qa.y, qb.x, qb.y};
            }
            const int tok = 4 * quad + (c16 >> 2);
            const int po = 16 * (((c16 & 3) >> 1) ^ (tok >> 3)) + 8 * (c16 & 1);
            const v2u vtr = __builtin_bit_cast(v2u, __builtin_amdgcn_ds_read_tr16_b64_v4i16((LAS s16x4*)(sb + HF_VT + tok * 256 + 32 * (wave ^ (tok & 7)) + po)));
#pragma unroll
            for (int t = 0; t < 8; ++t) ktr[t] = __builtin_bit_cast(v2u, __builtin_amdgcn_ds_read_tr16_b64_v4i16((LAS s16x4*)(sb + HF_KT + tok * 256 + 32 * (t ^ (tok & 7)) + po)));
#if defined(PROBE_SEC) && PROBE_SEC < 10
            asm volatile("s_waitcnt lgkmcnt(0)" ::: "memory");
            const unsigned long long tp3 = __builtin_amdgcn_s_memtime();
#endif
            __builtin_amdgcn_sched_barrier(0);
            const v4u vB4 = (v4u){vtr.x, vtr.y, 0u, 0u};
            pg8::f32x4 PT = (pg8::f32x4){0.f, 0.f, 0.f, 0.f};
#pragma unroll
            for (int kk = 0; kk < 4; ++kk) PT = MFMA16(__builtin_bit_cast(pg8::bf16x8, kf[kk]), __builtin_bit_cast(pg8::bf16x8, qf[kk]), PT);
            pg8::f32x4 oacc = (pg8::f32x4){0.f, 0.f, 0.f, 0.f};
#pragma unroll
            for (int kk = 0; kk < 4; ++kk) {
                const v4u rB = (v4u){pkbf(R[2 * kk][0], R[2 * kk][1]), pkbf(R[2 * kk][2], R[2 * kk][3]), pkbf(R[2 * kk + 1][0], R[2 * kk + 1][1]), pkbf(R[2 * kk + 1][2], R[2 * kk + 1][3])};
                oacc = MFMA16(__builtin_bit_cast(pg8::bf16x8, qf[kk]), __builtin_bit_cast(pg8::bf16x8, rB), oacc);
            }
#pragma unroll
            for (int t = 0; t < 8; ++t) { const v4u kA = (v4u){ktr[t].x, ktr[t].y, 0u, 0u}; R[t] = MFMA16(__builtin_bit_cast(pg8::bf16x8, kA), __builtin_bit_cast(pg8::bf16x8, vB4), R[t]); }
#pragma unroll
            for (int r = 0; r < 4; ++r) PT[r] = (4 * quad + r) <= c16 ? PT[r] : 0.f;
            const v4u pA = (v4u){pkbf(PT[0], PT[1]), pkbf(PT[2], PT[3]), 0u, 0u};
            oacc = MFMA16(__builtin_bit_cast(pg8::bf16x8, pA), __builtin_bit_cast(pg8::bf16x8, vB4), oacc);
#pragma unroll
            for (int t = 0; t < 8; ++t) { const pg8::f32x4 e4 = *(const LAS pg8::f32x4*)(sb + HF_EB + (16 * t + 4 * quad) * 4); R[t] = R[t] * e4; }
            {
                gbf16* op = O + (rowb + (size_t)ci * 16 + 4 * quad) * D + h * G_DV + 16 * wave + c16;
#pragma unroll
                for (int r = 0; r < 4; ++r) op[(size_t)r * D] = (bf16)(pkbf(oacc[r], 0.f) & 0xffffu);
            }
#if defined(PROBE_SEC) && PROBE_SEC < 10
            { asm volatile("s_nop 0" :: "v"(R[0][0]), "v"(R[7][3]));
              const unsigned long long tp4 = __builtin_amdgcn_s_memtime();
              const unsigned long long d_ = PROBE_SEC == 0 ? tp1 - tp0 : PROBE_SEC == 1 ? tp2 - tp1 : PROBE_SEC == 2 ? tp3 - tp2 : PROBE_SEC == 3 ? tp4 - tp3 : tp4 - tp0;
              if (ci >= 8) probe_acc += d_; }
#endif
        }
#if defined(PROBE_SEC) && PROBE_SEC < 10
        if (blockIdx.x == 0 && F.tid == 0) *(GAS unsigned long long*)probe_out = probe_acc / (TP / 16 - 8);
#endif
#undef HF_DMA
        {
            gf32* sp = SoutP + ((size_t)(b * G_H + h) * G_DK + 4 * quad) * G_DV + 16 * wave + c16;
#pragma unroll
            for (int t = 0; t < 8; ++t)
#pragma unroll
                for (int r = 0; r < 4; ++r) sp[(size_t)(16 * t + r) * G_DV] = R[t][r];
        }
        asm volatile("s_waitcnt vmcnt(0) lgkmcnt(0)" ::: "memory"); __builtin_amdgcn_s_barrier(); asm volatile("" ::: "memory");
    }
}

__device__ __forceinline__ void mini_res_gemm(Frame& F, const gbf16* A, const gbf16* Wt, int K, gbf16* xb, gf32* ssq_out, float scale, const gf32* rt8 = nullptr  ) {
    LAS unsigned char* L = F.lds + RING_OFF;
    const int lane = F.lane, wave = F.wave, r16 = lane & 15, quad = lane >> 4;
    const int kw = K >> 3, nks = kw >> 5;
    for (int tile = blockIdx.x; tile < 256; tile += F.G) {
        const int rt = tile >> 4, ct = tile & 15;
        const gbf16* ap = A + (size_t)(MP + 32 * rt + (lane >> 2)) * K + wave * kw + 8 * (lane & 3);
        const gbf16* bp = Wt + (size_t)(64 * ct + (lane >> 2)) * K + wave * kw + 8 * (lane & 3);
        const int psrc = (4 * r16 + quad) * 4;
        pg8::f32x4 acc[2][4];
#pragma unroll
        for (int i = 0; i < 2; ++i)
#pragma unroll
            for (int j = 0; j < 4; ++j) acc[i][j] = (pg8::f32x4){0.f, 0.f, 0.f, 0.f};
        v4u fa[2][2], fb[2][4];
#pragma unroll
        for (int i = 0; i < 2; ++i) fa[0][i] = *(const GAS v4u*)(ap + (size_t)(16 * i) * K);
#pragma unroll
        for (int j = 0; j < 4; ++j) fb[0][j] = *(const GAS v4u*)(bp + (size_t)(16 * j) * K);
        for (int ks = 0; ks < nks; ks += 2) {
#pragma unroll
            for (int half = 0; half < 2; ++half) {
                const int kn = ks + half + 1;
                const int ko = 32 * (kn < nks ? kn : nks - 1);
#pragma unroll
                for (int i = 0; i < 2; ++i) fa[half ^ 1][i] = *(const GAS v4u*)(ap + (size_t)(16 * i) * K + ko);
#pragma unroll
                for (int j = 0; j < 4; ++j) fb[half ^ 1][j] = *(const GAS v4u*)(bp + (size_t)(16 * j) * K + ko);
                __builtin_amdgcn_sched_barrier(0);
                if (ks + half < nks) {
#pragma unroll
                    for (int i = 0; i < 2; ++i) { v4u& x = fa[half][i]; x.x = __builtin_amdgcn_ds_bpermute(psrc, x.x); x.y = __builtin_amdgcn_ds_bpermute(psrc, x.y); x.z = __builtin_amdgcn_ds_bpermute(psrc, x.z); x.w = __builtin_amdgcn_ds_bpermute(psrc, x.w); }
#pragma unroll
                    for (int j = 0; j < 4; ++j) { v4u& x = fb[half][j]; x.x = __builtin_amdgcn_ds_bpermute(psrc, x.x); x.y = __builtin_amdgcn_ds_bpermute(psrc, x.y); x.z = __builtin_amdgcn_ds_bpermute(psrc, x.z); x.w = __builtin_amdgcn_ds_bpermute(psrc, x.w); }
#pragma unroll
                    for (int i = 0; i < 2; ++i)
#pragma unroll
                        for (int j = 0; j < 4; ++j) acc[i][j] = MFMA16(__builtin_bit_cast(pg8::bf16x8, fb[half][j]), __builtin_bit_cast(pg8::bf16x8, fa[half][i]), acc[i][j]);
                }
                __builtin_amdgcn_sched_barrier(0);
            }
        }
        if (rt8) {
#pragma unroll
            for (int i = 0; i < 2; ++i) { const float r = ret_head_rstd(rt8, MP + 32 * rt + 16 * i + r16, wave >> 1);
#pragma unroll
                for (int j = 0; j < 4; ++j) acc[i][j] = acc[i][j] * r; }
        }
#pragma unroll
        for (int i = 0; i < 2; ++i)
#pragma unroll
            for (int j = 0; j < 4; ++j) *(LAS pg8::f32x4*)(L + wave * 8192 + (16 * i + r16) * 256 + (16 * j + 4 * quad) * 4) = acc[i][j];
        LDS_WAIT(); __syncthreads();
        {
            const int row = F.tid >> 4, c4 = F.tid & 15;
            pg8::f32x4 s = *(const LAS pg8::f32x4*)(L + row * 256 + c4 * 16);
#pragma unroll
            for (int w = 1; w < 8; ++w) s = s + *(const LAS pg8::f32x4*)(L + w * 8192 + row * 256 + c4 * 16);
            const size_t off = (size_t)(MP + 32 * rt + row) * D + 64 * ct + 4 * c4;
            const v2u hh = *(const GAS v2u*)(xb + off);
            const pg8::f32x4 x = (pg8::f32x4){bflo(hh.x), bfhi(hh.x), bflo(hh.y), bfhi(hh.y)} + s * scale;
            v2u wb; wb.x = pkbf(x[0], x[1]); wb.y = pkbf(x[2], x[3]);
            *(GAS v2u*)(xb + off) = wb;

            float ss = (x[0] * x[0] + x[1] * x[1]) + (x[2] * x[2] + x[3] * x[3]);
            ss += __shfl_xor(ss, 1); ss += __shfl_xor(ss, 2); ss += __shfl_xor(ss, 4); ss += __shfl_xor(ss, 8);
            if (c4 == 0) ssq_out[(size_t)(MP + 32 * rt + row) * SSQ_SLOTS + ct] = ss;
        }
        LDS_WAIT(); __syncthreads();
    }
}

constexpr int R3_KT = 0, R3_VT = 65536, R3_RT = 81920, R3_QT = 114688, R3_QK = 147456, R3_END = 155648;
static_assert(R3_END <= RING_BYTES, "retention LDS map");

__device__ __forceinline__ void ret_rec3(Frame& F, const gbf16* Qh, const gbf16* Kt, const gbf16* V, const gf32* gC, const gbf16* Gt, gbf16* OBg, gf32* SSQo,
                                         const gf32* S0, gf32* SoutP, gf32* SoutS, GAS void* probe_out) {
    LAS unsigned char* L = F.lds + RING_OFF;
    const unsigned Lb = (unsigned)(size_t)L;
    const int wave = F.wave;
    constexpr int NCH = TP / R_C;
    for (int u = blockIdx.x; u < NSEQ_P * R_H * 8; u += F.G) {
        { int t_ = F.tid; unsigned z_ = 0; asm volatile("" : "+v"(t_), "+v"(z_));
          for (int i = t_; i < 32768 / 16; i += NWAVES * 64) *(LAS v4u*)(L + R3_RT + i * 16) = (v4u){z_, z_, z_, z_}; }
        if (wave < 4) {
            const int tt = (wave >> 1) & 1, et = wave & 1, dtb = 4 * tt;
            const int pair = (u & 7) * 4 + ((u >> 3) >> 3), sl = (u >> 3) & 7;
            const int b = pair >> 2, h = pair & 3;
            const int rowb = b * TP;
            const float gsc = gC[h * 2];
            int lane0 = F.lane; asm volatile("" : "+v"(lane0));
            f32x16 racc[4];
#pragma unroll
            for (int i = 0; i < 4; ++i)
#pragma unroll
                for (int r = 0; r < 16; ++r) racc[i][r] = 0.f;
#if defined(PROBE_SEC) && PROBE_SEC >= 20
            unsigned long long qprobe = 0, qbest = ~0ull;
#endif
#pragma unroll 1
            for (int c = 0; c < NCH; ++c) {
                const int crow0 = rowb + c * R_C;
                int lane = F.lane; asm volatile("" : "+v"(lane));
                const int l31 = lane & 31, hh = lane >> 5, i16 = lane & 15, q4 = i16 >> 2, p4 = i16 & 3, gb = (lane >> 4) & 1;
                const int erow = 32 * et + l31, esw = swz16(erow), ksw = swz16(l31);
                LAS unsigned char* KTb = L + R3_KT + (c & 1) * 32768;
                LAS unsigned char* VTb = L + R3_VT + (c & 1) * 8192;
#if defined(PROBE_SEC) && PROBE_SEC >= 20
                const unsigned long long qq0 = __builtin_amdgcn_s_memtime();
#endif
                asm volatile("s_waitcnt lgkmcnt(0)" ::: "memory");
                __builtin_amdgcn_s_barrier(); asm volatile("" ::: "memory");
#if defined(PROBE_SEC) && PROBE_SEC >= 20
                const unsigned long long qq1 = __builtin_amdgcn_s_memtime();
#endif
                v2u gfr[4];
#pragma unroll
                for (int i = 0; i < 4; ++i) gfr[i] = *(const GAS v2u*)(Gt + (size_t)(crow0 + 32 * tt + 8 * i + (lane >> 3)) * R_V + h * R_DV + sl * 64 + 32 * et + 4 * (lane & 7));
                s16x8 qf[16];
                {
                    LAS unsigned char* qrow = L + R3_QT + (32 * tt + l31) * 512;
#pragma unroll
                    for (int ks = 0; ks < 16; ++ks) qf[ks] = *(const LAS s16x8*)(qrow + 16 * ((2 * ks + hh) ^ ksw));
                }
                asm volatile("s_waitcnt lgkmcnt(0)" ::: "memory"); __builtin_amdgcn_s_barrier(); asm volatile("" ::: "memory");
                f32x16 oacc;
#pragma unroll
                for (int r = 0; r < 16; ++r) oacc[r] = 0.f;
#pragma unroll
                for (int ks = 0; ks < 16; ++ks) {
                    const s16x8 rf = *(const LAS s16x8*)(L + R3_RT + erow * 512 + 16 * ((2 * ks + hh) ^ esw));
                    oacc = MFMA32(qf[ks], rf, oacc);
                }
#if defined(PROBE_SEC) && PROBE_SEC >= 20
                asm volatile("s_nop 0" :: "v"(oacc[0]), "v"(oacc[15]));
#endif
#if defined(PROBE_SEC) && PROBE_SEC >= 20
                const unsigned long long qq2 = __builtin_amdgcn_s_memtime();
#endif
                LAS unsigned char* vbase = VTb + (4 * hh + q4) * 128 + 16 * ((4 * et + 2 * gb + (p4 >> 1)) ^ (((q4 >> 1) & 1) << 2)) + 8 * (p4 & 1);
#pragma unroll 1
                for (int st = 0; st <= tt; ++st) {
                    f32x16 X;
#pragma unroll
                    for (int r = 0; r < 16; ++r) X[r] = 0.f;
                    LAS unsigned char* kb_ = KTb + (32 * st + l31) * 512;
#pragma unroll
                    for (int ks = 0; ks < 16; ++ks) { const s16x8 kf = *(const LAS s16x8*)(kb_ + 16 * ((2 * ks + hh) ^ ksw)); X = MFMA32(kf, qf[ks], X); }
                    if (st == tt) {
#pragma unroll
                        for (int r = 0; r < 16; ++r) { const int sl_ = (r & 3) + 8 * (r >> 2) + 4 * hh; X[r] = sl_ <= l31 ? X[r] : 0.f; }
                    }
#pragma unroll
                    for (int s2 = 0; s2 < 2; ++s2) {
                        LAS unsigned char* vp = vbase + (2 * st + s2) * 2048;
                        const s16x8 vf = tr_pair(vp, vp + 1024);
                        v4u pk; pk.x = pkbf(X[8 * s2 + 0], X[8 * s2 + 1]); pk.y = pkbf(X[8 * s2 + 2], X[8 * s2 + 3]); pk.z = pkbf(X[8 * s2 + 4], X[8 * s2 + 5]); pk.w = pkbf(X[8 * s2 + 6], X[8 * s2 + 7]);
                        oacc = MFMA32(__builtin_bit_cast(s16x8, pk), vf, oacc);
                    }
                }
#if defined(PROBE_SEC) && PROBE_SEC >= 20
                asm volatile("s_nop 0" :: "v"(oacc[0]), "v"(oacc[15]));
#endif
#if defined(PROBE_SEC) && PROBE_SEC >= 20
                const unsigned long long qq3 = __builtin_amdgcn_s_memtime();
#endif
#if defined(PROBE_SEC) && PROBE_SEC >= 20
                const unsigned long long qq4 = __builtin_amdgcn_s_memtime();
#endif
                {
                    LAS unsigned char* kt0 = KTb + (4 * hh + q4) * 512 + 8 * (p4 & 1);
                    const int sw0 = (q4 << 2) | hh, sw1 = (q4 << 2) | ((hh + 2) & 3);
                    const int cl = 2 * gb + (p4 >> 1);
#pragma unroll
                    for (int k8 = 0; k8 < R_C / 16; ++k8) {
                        LAS unsigned char* vp = vbase + k8 * 2048;
                        const s16x8 vf = tr_pair(vp, vp + 1024);
#pragma unroll
                        for (int i = 0; i < 4; ++i) {
                            const int o0 = 16 * ((4 * (dtb + i) + cl) ^ sw0), o1 = 16 * ((4 * (dtb + i) + cl) ^ sw1) + 8 * 512;
                            const s16x8 ka = tr_pair(kt0 + k8 * 8192 + o0, kt0 + k8 * 8192 + o1); racc[i] = MFMA32(ka, vf, racc[i]);
                        }
                    }
                }
#pragma unroll
                for (int i = 0; i < 4; ++i)
#pragma unroll
                    for (int r = 0; r < 16; ++r) racc[i][r] *= gsc;
#if defined(PROBE_SEC) && PROBE_SEC >= 20
                asm volatile("s_nop 0" :: "v"(racc[0][0]), "v"(racc[3][15]));
#endif
#if defined(PROBE_SEC) && PROBE_SEC >= 20
                const unsigned long long qq5 = __builtin_amdgcn_s_memtime();
#endif
                asm volatile("s_waitcnt lgkmcnt(0)" ::: "memory"); __builtin_amdgcn_s_barrier(); asm volatile("" ::: "memory");
#if defined(PROBE_SEC) && PROBE_SEC >= 20
                const unsigned long long qq6 = __builtin_amdgcn_s_memtime();
#endif
                LAS unsigned char* OTb = KTb + wave * 4096;
                {
                    LAS float* ox = (LAS float*)OTb + (4 * hh) * 32 + l31;
#pragma unroll
                    for (int r = 0; r < 16; ++r) ox[((r & 3) + 8 * (r >> 2)) * 32] = oacc[r];
                }
#pragma unroll
                for (int i = 0; i < 4; ++i) {
                    const int trow = 8 * i + (lane >> 3);
                    const pg8::f32x4 o = *(const LAS pg8::f32x4*)(OTb + trow * 128 + (lane & 7) * 16);
                    const size_t oi = (size_t)(crow0 + 32 * tt + trow) * R_V + h * R_DV + sl * 64 + 32 * et + 4 * (lane & 7);
                    v2u wv; wv.x = pkbf(o[0] * bflo(gfr[i].x), o[1] * bfhi(gfr[i].x)); wv.y = pkbf(o[2] * bflo(gfr[i].y), o[3] * bfhi(gfr[i].y));
                    *(GAS v2u*)(OBg + oi) = wv;
                    float ssq = (o[0] * o[0] + o[1] * o[1]) + (o[2] * o[2] + o[3] * o[3]);
                    ssq += __shfl_xor(ssq, 1); ssq += __shfl_xor(ssq, 2); ssq += __shfl_xor(ssq, 4);
                    if ((lane & 7) == 0) SSQo[(size_t)(crow0 + 32 * tt + trow) * 64 + h * 16 + sl * 2 + et] = ssq;
                }
                if (c + 1 < NCH) {
#pragma unroll
                    for (int i = 0; i < 4; ++i) {
#pragma unroll
                        for (int g = 0; g < 4; ++g) {
                            v2u w; w.x = pkbf(racc[i][4 * g], racc[i][4 * g + 1]); w.y = pkbf(racc[i][4 * g + 2], racc[i][4 * g + 3]);
                            *(LAS v2u*)(L + R3_RT + erow * 512 + 16 * ((4 * (dtb + i) + g) ^ esw) + 8 * hh) = w;
                        }
                    }
                }
#if defined(PROBE_SEC) && PROBE_SEC >= 20
                { const unsigned long long qq7 = __builtin_amdgcn_s_memtime();
                  const unsigned long long d_ = PROBE_SEC == 20 ? qq1 - qq0 : PROBE_SEC == 21 ? qq2 - qq1 : PROBE_SEC == 22 ? qq3 - qq2 : PROBE_SEC == 23 ? qq4 - qq3 : PROBE_SEC == 24 ? qq5 - qq4 : PROBE_SEC == 25 ? qq6 - qq5 : PROBE_SEC == 26 ? qq7 - qq6 : PROBE_SEC == 28 ? qq3 - qq1 : qq7 - qq0;
                  if (c >= 2 && qq7 - qq0 < qbest) { qbest = qq7 - qq0; qprobe = d_; } }
#endif
            }
#if defined(PROBE_SEC) && PROBE_SEC >= 20
            if (blockIdx.x == 0 && F.tid == PROBE_WAVE * 64) *(GAS unsigned long long*)probe_out = ((qprobe + PROBE_Q / 2) / PROBE_Q) * PROBE_Q;
#endif
            {
                const int l31 = lane0 & 31, hh = lane0 >> 5;
                gf32* sp_ = SoutP + ((size_t)(b * R_H + h) * R_DK + 4 * hh) * R_DV + sl * 64 + 32 * et + l31;
#pragma unroll
                for (int i = 0; i < 4; ++i) {
#pragma unroll
                    for (int r = 0; r < 16; ++r) sp_[(size_t)(32 * (dtb + i) + (r & 3) + 8 * (r >> 2)) * R_DV] = racc[i][r];
                }
            }
        } else {
            const int w4 = wave & 3, spl = w4 >> 1, half = w4 & 1;
            int lane = F.lane; asm volatile("" : "+v"(lane));
            const int sp = 2 * u + spl, ss = sp >> 2, sh = sp & 3, srow = MP + 4 * ss;
            const float gs4 = gC[sh * 2 + 1];
            const size_t sbase = ((size_t)(ss * R_H + sh) * R_DK) * R_DV + 256 * half + 4 * lane;
            float so[4][4], sv[4][4];
#pragma unroll
            for (int t = 0; t < 4; ++t) { const v2u vv = *(const GAS v2u*)(V + (size_t)(srow + t) * R_V + sh * R_DV + 256 * half + 4 * lane);
                sv[t][0] = bflo(vv.x); sv[t][1] = bfhi(vv.x); sv[t][2] = bflo(vv.y); sv[t][3] = bfhi(vv.y);
                so[t][0] = 0.f; so[t][1] = 0.f; so[t][2] = 0.f; so[t][3] = 0.f; }
            if (half == 0) {
#pragma unroll
                for (int t = 0; t < 4; ++t)
#pragma unroll
                    for (int i = 0; i < 4; ++i) { const int d = lane + 64 * i; const size_t gi = (size_t)(srow + t) * R_QK + sh * R_DK + d;
                        *(LAS unsigned short*)(L + R3_QK + spl * 4096 + d * 16 + t * 4) = Qh[gi]; *(LAS unsigned short*)(L + R3_QK + spl * 4096 + d * 16 + t * 4 + 2) = Kt[gi]; }
            }
            const int ppair = (u & 7) * 4 + ((u >> 3) >> 3), psl = (u >> 3) & 7, pb_ = ppair >> 2, ph = ppair & 3, prowb = pb_ * TP;
#define R3_DMA(c_) do { unsigned lb_ = Lb; asm volatile("" : "+s"(lb_)); const int cr0_ = prowb + (c_) * R_C; const unsigned kb_ = lb_ + R3_KT + ((c_) & 1) * 32768 + 16 * w4 * 512, vb_ = lb_ + R3_VT + ((c_) & 1) * 8192 + 16 * w4 * 128; \
            _Pragma("unroll") for (int i_ = 0; i_ < 8; ++i_) { const int row_ = 16 * w4 + 2 * i_ + (lane >> 5), ch_ = (lane & 31) ^ swz16(row_); \
                glds16_asm((const GAS void*)(Kt + (size_t)(cr0_ + row_) * R_QK + ph * R_DK + 8 * ch_), __builtin_amdgcn_readfirstlane(kb_ + i_ * 1024)); } \
            _Pragma("unroll") for (int i_ = 0; i_ < 2; ++i_) { const int row_ = 16 * w4 + 8 * i_ + (lane >> 3), ch_ = (lane & 7) ^ (((row_ >> 1) & 1) << 2); \
              glds16_asm((const GAS void*)(V + (size_t)(cr0_ + row_) * R_V + ph * R_DV + psl * 64 + 8 * ch_), __builtin_amdgcn_readfirstlane(vb_ + i_ * 1024)); } } while (0)
#define R3_DMAQ(c_) do { unsigned lb_ = Lb; asm volatile("" : "+s"(lb_)); const int cr0_ = prowb + (c_) * R_C; const unsigned qb_ = lb_ + R3_QT + 16 * w4 * 512; \
            _Pragma("unroll") for (int i_ = 0; i_ < 8; ++i_) { const int row_ = 16 * w4 + 2 * i_ + (lane >> 5), ch_ = (lane & 31) ^ swz16(row_); \
                glds16_asm((const GAS void*)(Qh + (size_t)(cr0_ + row_) * R_QK + ph * R_DK + 8 * ch_), __builtin_amdgcn_readfirstlane(qb_ + i_ * 1024)); } } while (0)
            R3_DMA(0); R3_DMAQ(0);
            asm volatile("s_waitcnt vmcnt(0)" ::: "memory");
            pg8::f32x4 sA[8], sB[8];
#pragma unroll
            for (int r = 0; r < 8; ++r) sA[r] = *(const gf32x4*)(S0 + sbase + (size_t)r * R_DV);
#define R3_SSTEP(c_, cur_, nxt_) do { \
                asm volatile("" : "+v"(lane)); const size_t sbase = ((size_t)(ss * R_H + sh) * R_DK) * R_DV + 256 * half + 4 * lane;      \
                  \
                asm volatile("s_waitcnt vmcnt(16) lgkmcnt(0)" ::: "memory"); __builtin_amdgcn_s_barrier(); asm volatile("" ::: "memory"); \
                if ((c_) + 1 < NCH) R3_DMA((c_) + 1); \
                __builtin_amdgcn_s_barrier(); asm volatile("" ::: "memory");                                                                \
                if ((c_) + 1 < NCH) { R3_DMAQ((c_) + 1); \
                    _Pragma("unroll") for (int r = 0; r < 8; ++r) nxt_[r] = *(const gf32x4*)(S0 + sbase + (size_t)(8 * ((c_) + 1) + r) * R_DV); } \
                asm volatile("s_waitcnt lgkmcnt(0)" ::: "memory"); __builtin_amdgcn_s_barrier(); asm volatile("" ::: "memory");            \
                _Pragma("unroll") for (int r = 0; r < 8; ++r) { \
                    const v4u qk = *(const LAS v4u*)(L + R3_QK + spl * 4096 + (8 * (c_) + r) * 16); \
                    const float q0 = bflo(qk.x), k0 = bfhi(qk.x), q1 = bflo(qk.y), k1 = bfhi(qk.y), q2 = bflo(qk.z), k2 = bfhi(qk.z), q3 = bflo(qk.w), k3 = bfhi(qk.w); \
                    pg8::f32x4 w; \
                    _Pragma("unroll") for (int cc = 0; cc < 4; ++cc) { \
                        float x = cur_[r][cc]; \
                        x += k0 * sv[0][cc]; so[0][cc] += q0 * x; \
                        x += k1 * sv[1][cc]; so[1][cc] += q1 * x; \
                        x += k2 * sv[2][cc]; so[2][cc] += q2 * x; \
                        x += k3 * sv[3][cc]; so[3][cc] += q3 * x; \
                        w[cc] = x * gs4; \
                    } \
                    *(gf32x4*)(SoutS + sbase + (size_t)(8 * (c_) + r) * R_DV) = w; \
                } } while (0)
#pragma unroll 1
            for (int c = 0; c < NCH; c += 2) { R3_SSTEP(c, sA, sB); R3_SSTEP(c + 1, sB, sA); }
#undef R3_SSTEP
#undef R3_DMA
#undef R3_DMAQ
#pragma unroll
            for (int t = 0; t < 4; ++t) {
                const size_t oi = (size_t)(srow + t) * R_V + sh * R_DV + 256 * half + 4 * lane;
                const v2u g = *(const GAS v2u*)(Gt + oi);
                v2u wv; wv.x = pkbf(so[t][0] * bflo(g.x), so[t][1] * bfhi(g.x)); wv.y = pkbf(so[t][2] * bflo(g.y), so[t][3] * bfhi(g.y));
                *(GAS v2u*)(OBg + oi) = wv;
                float ssq = (so[t][0] * so[t][0] + so[t][1] * so[t][1]) + (so[t][2] * so[t][2] + so[t][3] * so[t][3]);
                ssq += __shfl_xor(ssq, 1); ssq += __shfl_xor(ssq, 2); ssq += __shfl_xor(ssq, 4);
                if ((lane & 7) == 0) SSQo[(size_t)(srow + t) * 64 + sh * 16 + 8 * half + (lane >> 3)] = ssq;
            }
        }
        asm volatile("s_waitcnt vmcnt(0) lgkmcnt(0)" ::: "memory"); __builtin_amdgcn_s_barrier(); asm volatile("" ::: "memory");
    }
}

#ifndef PROBE_SCALE
#define PROBE_SCALE 0.05f
#endif
#ifndef PROBE_MASK
#define PROBE_MASK 0
#endif
#define PREP(type) for (int rep_ = 0; rep_ < 1 + ((PROBE_MASK >> (type)) & 1); ++rep_)
#define PSC(type, s) ((rep_ == 0) ? (s) : 0.0f)
#define PBAR(type) do { if (((PROBE_MASK >> (type)) & 1) && rep_ == 0 && use_bar) xcd_barrier(bar); } while (0)
#ifndef MK_PER_PHASE_LAUNCH
#define MK_PER_PHASE_LAUNCH 0
#endif
constexpr size_t OUT_Y = 0, OUT_RETP = (size_t)M * D, OUT_RETS = OUT_RETP + (size_t)2 * 8 * 4 * 256 * 512, OUT_HGP = OUT_RETS + (size_t)2 * 128 * 4 * 256 * 512,
                 OUT_HGS = OUT_HGP + (size_t)2 * 8 * 8 * 128 * 128, OUT_END = OUT_HGS + (size_t)2 * 128 * 8 * 128 * 128;
static_assert(OUT_END == 195559424, "output size");

template <class T> __device__ __forceinline__ GAS T* opaque(GAS T* p) { asm volatile("" : "+s"(p)); return p; }
__device__ __forceinline__ Frame local_frame(const Frame& F) {
    Frame L = F; int t = threadIdx.x; asm volatile("" : "+v"(t)); L.tid = t; L.lane = t & 63; L.wave = __builtin_amdgcn_readfirstlane(t >> 6); return L; }
struct Args { const float* in[15]; float* out; unsigned char* ws; int ph_lo, ph_hi; };

#define SSQ_PTR(ws, idx) ((gf32*)((ws) + WS_SSQ) + (size_t)(idx) * M * SSQ_SLOTS)

__device__ __forceinline__ void tail_convert(Frame& F_, GAS unsigned char* ws_, const GAS void* kargs_, int layer, int q0, int q1, int nunits) {
    const int nextra = nunits % F_.G;
    if (layer >= 4 || nextra == 0 || (int)blockIdx.x < nextra) return;
    Frame F = local_frame(F_); GAS unsigned char* ws = opaque(ws_);
    const GAS Args* ka = (const GAS Args*)opaque((const GAS unsigned char*)kargs_);
#define KIN(i) ((const gf32*)ka->in[i])
    PrologueArgs A{KIN(0), KIN(1), KIN(4), KIN(5), KIN(6), KIN(7), KIN(8), KIN(9), KIN(10), KIN(11), KIN(12), KIN(13), ws};
#undef KIN
    convert_layer_weights(F, A, layer, q0, q1, ((int)blockIdx.x - nextra) * NWAVES + F.wave, (F.G - nextra) * NWAVES);
}
__device__ __forceinline__ void ffn_up(Frame& F, GAS unsigned char* ws_, int idx, int ssq_idx) {
    GAS unsigned char* ws = opaque(ws_);
    pg8::Gemm g{(const bf16*)(ws + WS_XB), (const bf16*)(ws + WS_W + idx * W_FFN_STRIDE), M, NUP, D};
    pg8::StaticOrder S; S.init(M, NUP, F.G, (int)blockIdx.x);
    EpiUp E{(gbf16*)(ws + WS_HID), stage_row_rstd(F.lds, S, SSQ_PTR(ws, ssq_idx), (int)threadIdx.x)};
    pg8::gemm_phase<EpiUp, pg8::StaticOrder, true, true>(F.lds + RING_OFF, g, S, E);
}
__device__ __forceinline__ void res_gemm(Frame& F, GAS unsigned char* ws_, size_t a_off, size_t w_off, int K, int ssq_idx, float scale) {
    GAS unsigned char* ws = opaque(ws_);
    pg8::Gemm g{(const bf16*)(ws + a_off), (const bf16*)(ws + w_off), MP, D, K};
    pg8::StaticOrder S; S.init(MP, D, F.G, (int)blockIdx.x);
    EpiRes E{(gbf16*)(ws + WS_XB), SSQ_PTR(ws, ssq_idx), scale};
    pg8::gemm_phase<EpiRes, pg8::StaticOrder, true, true>(F.lds + RING_OFF, g, S, E);
    Frame FL = local_frame(F);
    mini_res_gemm(FL, (const gbf16*)(ws + a_off), (const gbf16*)(ws + w_off), K, (gbf16*)(ws + WS_XB), SSQ_PTR(ws, ssq_idx), scale);
}
__device__ __forceinline__ void res_gemm_ks(Frame& F, GAS unsigned char* ws_, size_t a_off, size_t w_off, int K, int ssq_idx, float scale) {
    GAS unsigned char* ws = opaque(ws_);
    pg8::Gemm g{(const bf16*)(ws + a_off), (const bf16*)(ws + w_off), MP, D, K};
    pg8::StaticOrder S; S.init(MP, D, F.G, (int)blockIdx.x);
    LAS unsigned char* lfac = F.lds + 131072;
    { int t_ = F.tid; asm volatile("" : "+v"(t_)); pg8::Unit u0; if (S.next(0, u0) && t_ < 256) { const gf32* sq = (const gf32*)(ws + WS_SSQO); const int row = u0.pm * 256 + t_;
        const float r0 = ret_head_rstd(sq, row, 0), r1 = ret_head_rstd(sq, row, 1), r2 = ret_head_rstd(sq, row, 2), r3 = ret_head_rstd(sq, row, 3);
        *(LAS f32x4*)(lfac + t_ * 16) = (f32x4){r0 / r1, r1 / r2, r2 / r3, r3}; } }
    LDS_WAIT(); __syncthreads();
    EpiResKS E{{(gbf16*)(ws + WS_XB), SSQ_PTR(ws, ssq_idx), scale}, lfac};
    pg8::gemm_phase<EpiResKS, pg8::StaticOrder, true, true>(F.lds + RING_OFF, g, S, E);
    Frame FL = local_frame(F);
    mini_res_gemm(FL, (const gbf16*)(ws + a_off), (const gbf16*)(ws + w_off), K, (gbf16*)(ws + WS_XB), SSQ_PTR(ws, ssq_idx), scale, (const gf32*)(ws + WS_SSQO));
}
__device__ __forceinline__ void ret_in_gemm(Frame& F, GAS unsigned char* ws_, int j, int ssq_idx) {
    GAS unsigned char* ws = opaque(ws_); const gf32* tab2 = (const gf32*)(ws + WS_TAB2);
    pg8::Gemm g{(const bf16*)(ws + WS_XB), (const bf16*)(ws + WS_W + W_RET_BASE + j * W_RET_STRIDE), M, R_NIN, D};
    pg8::StaticOrder S; S.init(M, R_NIN, F.G, (int)blockIdx.x);
    EpiRetIn E{(gbf16*)(ws + WS_QB), (gbf16*)(ws + WS_KB), (gbf16*)(ws + WS_VB), (gbf16*)(ws + WS_GB), stage_row_rstd(F.lds, S, SSQ_PTR(ws, ssq_idx), (int)threadIdx.x), (const gf32*)(ws + WS_ROPE), tab2, tab2 + 512};
    pg8::gemm_phase<EpiRetIn, pg8::StaticOrder, true, true>(F.lds + RING_OFF, g, S, E);
}
__device__ __forceinline__ void hg_in_gemm(Frame& F, GAS unsigned char* ws_, int j, int ssq_idx) {
    GAS unsigned char* ws = opaque(ws_); const gf32* tab2 = (const gf32*)(ws + WS_TAB2);
    pg8::Gemm g{(const bf16*)(ws + WS_XB), (const bf16*)(ws + WS_W + W_HG_BASE + j * W_HG_STRIDE), M, G_NIN, D};
    pg8::StaticOrder S; S.init(M, G_NIN, F.G, (int)blockIdx.x);
    EpiHgIn E{(gbf16*)(ws + WS_QB), (gbf16*)(ws + WS_KB), (gbf16*)(ws + WS_VB), (gbf16*)(ws + WS_GB), (gf32*)(ws + WS_EB), stage_row_rstd(F.lds, S, SSQ_PTR(ws, ssq_idx), (int)threadIdx.x), tab2 + 2048 + j * 1024};
    pg8::gemm_phase<EpiHgIn, pg8::StaticOrder, true, true>(F.lds + RING_OFF, g, S, E);
}
__device__ __forceinline__ void ret_rec(Frame& F_, GAS unsigned char* ws_, const gf32* st_, gf32* out_, int j) {
    Frame F = local_frame(F_); GAS unsigned char* ws = opaque(ws_); const gf32* st = opaque(st_); gf32* out = opaque(out_);
    ret_rec3(F, (const gbf16*)(ws + WS_QB), (const gbf16*)(ws + WS_KB), (const gbf16*)(ws + WS_VB), (const gf32*)(ws + WS_TAB2) + 1024, (const gbf16*)(ws + WS_GB), (gbf16*)(ws + WS_OB), (gf32*)(ws + WS_SSQO),
             st + (size_t)j * NSEQ_S * R_H * R_DK * R_DV, out + OUT_RETP + (size_t)j * NSEQ_P * R_H * R_DK * R_DV, out + OUT_RETS + (size_t)j * NSEQ_S * R_H * R_DK * R_DV, (GAS void*)(ws + WS_CTL + 32768));
}
__device__ __forceinline__ void hg_rec(Frame& F_, GAS unsigned char* ws_, const gf32* st_, gf32* out_, int j) {
    Frame F = local_frame(F_); GAS unsigned char* ws = opaque(ws_); const gf32* st = opaque(st_); gf32* out = opaque(out_);
    PREP(12)
    hg_fast(F, (const gbf16*)(ws + WS_QB), (const gbf16*)(ws + WS_KB), (const gbf16*)(ws + WS_VB), (const gf32*)(ws + WS_EB), (gbf16*)(ws + WS_OF),
            out + OUT_HGP + (size_t)j * NSEQ_P * G_H * G_DK * G_DV, (GAS void*)(ws + WS_CTL + 32768));
    asm volatile("s_waitcnt vmcnt(0) lgkmcnt(0)" ::: "memory"); __syncthreads();
    rec_naive<G_DK, G_DV, G_H, G_C>(F, (const gbf16*)(ws + WS_QB), (const gbf16*)(ws + WS_KB), (const gbf16*)(ws + WS_VB), (const gf32*)(ws + WS_EB), nullptr,
                                    st + (size_t)j * NSEQ_S * G_H * G_DK * G_DV, (gbf16*)(ws + WS_OF),
                                    out + OUT_HGP + (size_t)j * NSEQ_P * G_H * G_DK * G_DV, out + OUT_HGS + (size_t)j * NSEQ_S * G_H * G_DK * G_DV, NSEQ_P * G_H * (G_DV / 64),
                                    F.G > 2 * NSEQ_P * G_H ? NSEQ_P * G_H : 0);
}

__global__ void __launch_bounds__(NWAVES * 64, 2) mk_fwd(Args args) {
    extern __shared__ __attribute__((aligned(16))) unsigned char lds[];
    Frame F;
    F.lds = (LAS unsigned char*)lds;
    F.MISC = (volatile LAS unsigned*)(F.lds + MISC_OFF);
    F.tid = threadIdx.x; F.lane = F.tid & 63; F.wave = __builtin_amdgcn_readfirstlane(F.tid >> 6);
    F.G = gridDim.x;
    GAS unsigned char* ws = (GAS unsigned char*)args.ws;
    const GAS void* kargs = (const GAS void*)__builtin_amdgcn_kernarg_segment_ptr();
    F.ctl = (gu32*)(ws + WS_CTL);
    for (int u = F.tid; u < (LDS_BYTES - LDSCTL_OFF) / 4; u += NWAVES * 64) ((LAS unsigned*)(F.lds + LDSCTL_OFF))[u] = 0u;
    __syncthreads();
    int lo = args.ph_lo, hi = args.ph_hi;
    const bool use_bar = (hi - lo) > 1;
    XcdBarrier bar; bar.bar = (unsigned*)(F.ctl + CW_BAR); bar.x = 0; bar.st = nullptr;
    if (use_bar) bar = xcd_barrier_post((unsigned*)(F.ctl + CW_BAR), F.MISC + 8);
#define IN(k) (lo <= (k) && (k) < hi)
#define SEAM(k) do { if (IN(k) && IN((k) + 1)) xcd_barrier(bar); } while (0)

    if (IN(0)) {
        Frame FL = local_frame(F);
        #define GIN(i) ((const gf32*)args.in[i])
        PrologueArgs A{GIN(0), GIN(1), GIN(4), GIN(5), GIN(6), GIN(7), GIN(8), GIN(9), GIN(10), GIN(11), GIN(12), GIN(13), ws};
        PREP(0) { p0_prologue(FL, A); PBAR(0); }
    }
    SEAM(0);

    for (int L = 0; L < 4; ++L) {
        const int pb = 1 + 8 * L, j = L >> 1;
        asm volatile("" : "+s"(lo), "+s"(hi));
        if (IN(pb + 0)) { PREP(1) { ffn_up(F, ws, 2 * L, 3 * L); PBAR(1); } tail_convert(F, ws, kargs, L + 1, 0, 1, (M / 256) * (NUP / 256)); }
        SEAM(pb + 0);
        if (IN(pb + 1)) PREP(2) { res_gemm(F, ws, WS_HID, WS_W + (2 * L) * W_FFN_STRIDE + W_DOWN_OFF, FF, 3 * L + 1, PSC(2, 0.5f)); PBAR(2); }
        SEAM(pb + 1);
        if ((L & 1) == 0) {
            if (IN(pb + 2)) { PREP(3) { ret_in_gemm(F, ws, j, 3 * L + 1); PBAR(3); } tail_convert(F, ws, kargs, L + 1, 1, 3, (M / 256) * (R_NIN / 256)); }
            SEAM(pb + 2);
            if (IN(pb + 3)) PREP(4) { ret_rec(F, ws, GIN(2), (gf32*)args.out, j); PBAR(4); }
            SEAM(pb + 3);
            if (IN(pb + 5)) PREP(6) { res_gemm_ks(F, ws, WS_OB, WS_W + W_RET_BASE + j * W_RET_STRIDE + W_ROUT_OFF, R_V, 3 * L + 2, PSC(6, 1.0f)); PBAR(6); }
            SEAM(pb + 5);
        } else {
            if (IN(pb + 2)) { PREP(7) { hg_in_gemm(F, ws, j, 3 * L + 1); PBAR(7); } tail_convert(F, ws, kargs, L + 1, 1, 3, (M / 256) * (G_NIN / 256)); }
            SEAM(pb + 2);
            if (IN(pb + 3)) PREP(8) { hg_rec(F, ws, GIN(3), (gf32*)args.out, j); PBAR(8); }
            SEAM(pb + 3);
            if (IN(pb + 4)) PREP(9) { PBAR(9); GAS unsigned char* w = opaque(ws); Frame FL = local_frame(F); headnorm_phase<G_DV>(FL, (const gbf16*)(w + WS_OF), (const gbf16*)(w + WS_GB), (gbf16*)(w + WS_OB), M * D / 512); }
            SEAM(pb + 4);
            if (IN(pb + 5)) PREP(10) { res_gemm(F, ws, WS_OB, WS_W + W_HG_BASE + j * W_HG_STRIDE + W_HOUT_OFF, D, 3 * L + 2, PSC(10, 1.0f)); PBAR(10); }
            SEAM(pb + 5);
        }
        if (IN(pb + 6)) { PREP(1) { ffn_up(F, ws, 2 * L + 1, 3 * L + 2); PBAR(1); } tail_convert(F, ws, kargs, L + 1, 3, 4, (M / 256) * (NUP / 256)); }
        SEAM(pb + 6);
        if (IN(pb + 7)) PREP(2) { res_gemm(F, ws, WS_HID, WS_W + (2 * L + 1) * W_FFN_STRIDE + W_DOWN_OFF, FF, 3 * L + 3, PSC(2, 0.5f)); PBAR(2); }
        SEAM(pb + 7);
    }
    if (IN(33)) { GAS unsigned char* w = opaque(ws); Frame FL = local_frame(F); final_phase(FL, (const gbf16*)(w + WS_XB), SSQ_PTR(w, 12), GIN(14), (gf32*)args.out + OUT_Y
#ifdef PROBE_SEC
            , 1.0f + PROBE_SCALE * (float)(*(const GAS unsigned long long*)(w + WS_CTL + 32768)) * 1e-3f
#else
            , 1.0f
#endif
            ); }
#undef IN
#undef SEAM
}

extern "C" void kernel_launch(void* const* d_in, const int* in_sizes, int n_in, void* d_out, int out_size, void* d_ws, size_t ws_size, hipStream_t stream) {
    static int grid = 0;
    if (grid == 0) {
        if (n_in != 15 || (size_t)out_size != OUT_END || ws_size < WS_END) { fprintf(stderr, "kernel_launch: unexpected shapes (n_in %d out %d ws %zu)\n", n_in, out_size, ws_size); grid = -1; return; }
        int dev = 0, cus = 0, per_cu = 0;
        if (hipGetDevice(&dev) != hipSuccess || hipDeviceGetAttribute(&cus, hipDeviceAttributeMultiprocessorCount, dev) != hipSuccess) { grid = -1; return; }
        if (hipFuncSetAttribute((const void*)mk_fwd, hipFuncAttributeMaxDynamicSharedMemorySize, LDS_BYTES) != hipSuccess) { fprintf(stderr, "kernel_launch: hipFuncSetAttribute failed\n"); grid = -1; return; }
        if (hipOccupancyMaxActiveBlocksPerMultiprocessor(&per_cu, (const void*)mk_fwd, NWAVES * 64, LDS_BYTES) != hipSuccess || per_cu < 1) { fprintf(stderr, "kernel_launch: occupancy query says %d\n", per_cu); per_cu = 1; }
        (void)hipGetLastError();
        grid = cus;
    }
    if (grid < 0) return;
    (void)hipMemsetAsync((char*)d_ws + WS_CTL, 0, CTL_ZERO_BYTES, stream);
    Args a{};
    for (int i = 0; i < 15; ++i) a.in[i] = (const float*)d_in[i];
    a.out = (float*)d_out; a.ws = (unsigned char*)d_ws;
#if MK_PER_PHASE_LAUNCH
    for (int p = 0; p < NPHASE; ++p) { a.ph_lo = p; a.ph_hi = p + 1; hipLaunchKernelGGL(mk_fwd, dim3(grid), dim3(NWAVES * 64), LDS_BYTES, stream, a); }
#else
    a.ph_lo = 0; a.ph_hi = NPHASE;
    hipLaunchKernelGGL(mk_fwd, dim3(grid), dim3(NWAVES * 64), LDS_BYTES, stream, a);
#endif
}
```

```cpp
#include <hip/hip_runtime.h>
#include <cstdio>
#include <cstdint>
namespace pg8 {
#define PG8_LAS __attribute__((address_space(3)))
typedef unsigned short bf16_t;
typedef short bf16x8 __attribute__((ext_vector_type(8)));
typedef float f32x4 __attribute__((ext_vector_type(4)));
typedef unsigned u32x4 __attribute__((ext_vector_type(4)));
constexpr int BM = 256, BK = 64, HALF = 128, HTB = HALF * BK * 2  , STAGE_BYTES = 8 * HTB, NXCD = 8, WGM = 8;

__host__ __device__ __forceinline__ int lds_byte(int r, int c) { const int st = (r >> 4) * 2 + (c >> 5), rr = r & 15, cc = c & 31, ob = rr * 64 + cc * 2; return st * 1024 + (ob ^ (((ob >> 9) & 1) << 5)); }
__host__ __device__ __forceinline__ void stage_rc(int b, int& R, int& C) { const int st = b / 1024, sb = b % 1024, swz = sb ^ (((sb >> 9) & 1) << 5); R = (st >> 1) * 16 + swz / 64; C = (st & 1) * 32 + (swz % 64) / 2; }
__host__ __device__ __forceinline__ int perm32(int rho) { const int n = rho >> 4, i = rho & 15; return 8 * (i >> 2) + 4 * n + (i & 3); }

struct Unit { int pm, pn, ord; };
struct Gemm { const bf16_t* A; const bf16_t* Bt; int M, N, K; };

struct StaticOrder {
    int nM, nN, nwg, G, c;
    __host__ __device__ void init(int M, int N, int G_, int c_) { nM = M / BM; nN = N / BM; nwg = nM * nN; G = G_; c = c_; }
    __host__ __device__ bool next(int i, Unit& u) const {
        const long L = (long)i * G + c; if (L >= nwg) return false;
        int wgid = (int)L; { const int q = nwg / NXCD, r = nwg % NXCD, xcd = wgid % NXCD, off = wgid / NXCD; wgid = (xcd < r ? xcd * (q + 1) : r * (q + 1) + (xcd - r) * q) + off; }
        const int nig = WGM * nN, gid = wgid / nig, fm = gid * WGM, gsz = (nM - fm) < WGM ? (nM - fm) : WGM;
        u.pm = fm + ((wgid % nig) % gsz); u.pn = (wgid % nig) / gsz; u.ord = i; return true;
    }
    __device__ __forceinline__ void a_ready(const Unit&) const {}
    __device__ __forceinline__ void done(const Unit&) const {}
};

__device__ __forceinline__ unsigned cvt_pk_bf16(float lo, float hi) { unsigned r; asm volatile("v_cvt_pk_bf16_f32 %0, %1, %2" : "=v"(r) : "v"(lo), "v"(hi)); return r; }
template <class Epi, class Sched, bool ALIGN_EPI = false, bool SP2 = false>
__device__ __forceinline__ void gemm_phase(PG8_LAS unsigned char* lds, const Gemm g, const Sched& S, const Epi& E) {
    int tid_ = threadIdx.x; asm volatile("" : "+v"(tid_));
    const int tid = tid_, wid = __builtin_amdgcn_readfirstlane(tid >> 6), lane = tid & 63, wr = wid >> 2, wc = wid & 3, fr = lane & 15, fq = lane >> 4;
    const int K = g.K, nt = K / BK;
    unsigned voffA[2], voffB[2];
#pragma unroll
    for (int i = 0; i < 2; ++i) { int R, C; stage_rc(tid * 16 + i * 8192, R, C); const int Rb = Epi::PERM ? ((R & ~31) + perm32(R & 31)) : R;
        voffA[i] = (unsigned)(R * K + C) * 2u; voffB[i] = (unsigned)(Rb * K + C) * 2u; }
    const size_t kstep = (size_t)(BK * 2);
    const size_t hstep = (size_t)HALF * K * 2;
    const size_t tstep = 2 * hstep;
    const unsigned ldsw = (unsigned)wid * 1024u;
    const int aoff = lds_byte(wr * 64 + fr, fq * 8), boff = lds_byte(wc * 32 + fr, fq * 8);
#define PG8_SA(b, h) (((b) * 2 + (h)) * HTB)
#define PG8_SB(b, h) ((4 + (b) * 2 + (h)) * HTB)
#define PG8_STAGE(bufoff, gbase, voff) do { _Pragma("unroll") for (int _i = 0; _i < 2; ++_i) \
        __builtin_amdgcn_global_load_lds((const unsigned*)((const char*)(gbase) + (voff)[_i]), (PG8_LAS unsigned*)(lds + (bufoff) + ldsw + _i * 8192), 16, 0, 0); } while (0)
#define PG8_LDA(dst, b, h) do { _Pragma("unroll") for (int m = 0; m < 4; ++m) _Pragma("unroll") for (int k = 0; k < 2; ++k) dst[m][k] = *(const PG8_LAS bf16x8*)(lds + PG8_SA(b, h) + aoff + m * 2048 + k * 1024); } while (0)
#define PG8_LDB(dst, b, h) do { _Pragma("unroll") for (int n = 0; n < 2; ++n) _Pragma("unroll") for (int k = 0; k < 2; ++k) dst[n][k] = *(const PG8_LAS bf16x8*)(lds + PG8_SB(b, h) + boff + n * 2048 + k * 1024); } while (0)
#define PG8_MMA(ai, bj, At, Bt) do { __builtin_amdgcn_s_setprio(1); _Pragma("unroll") for (int m = 0; m < 4; ++m) _Pragma("unroll") for (int n = 0; n < 2; ++n) _Pragma("unroll") for (int k = 0; k < 2; ++k) \
        acc[ai][bj][m][n] = __builtin_amdgcn_mfma_f32_16x16x32_bf16(Bt[n][k], At[m][k], acc[ai][bj][m][n], 0, 0, 0); __builtin_amdgcn_s_setprio(0); } while (0)
#define PG8_WAIT_V(n) asm volatile("s_waitcnt vmcnt(" #n ")" ::: "memory")
#define PG8_WAIT_L(n) asm volatile("s_waitcnt lgkmcnt(" #n ")" ::: "memory")
#define PG8_BAR __builtin_amdgcn_s_barrier()
#define PG8_SCHED __builtin_amdgcn_sched_barrier(0)
    Unit cur, nxt; int ui = 0;
    if (!S.next(0, cur)) return;
    f32x4 acc[2][2][4][2];
#pragma unroll
    for (int a = 0; a < 2; ++a)
#pragma unroll
        for (int b = 0; b < 2; ++b)
#pragma unroll
            for (int m = 0; m < 4; ++m)
#pragma unroll
                for (int n = 0; n < 2; ++n) acc[a][b][m][n] = (f32x4){0.f, 0.f, 0.f, 0.f};
    bf16x8 At[4][2], B0[2][2], B1[2][2];
    const char* cA = (const char*)g.A + (size_t)cur.pm * tstep; const char* cB = (const char*)g.Bt + (size_t)cur.pn * tstep;
    S.a_ready(cur);
    if constexpr (SP2) {
        PG8_STAGE(PG8_SB(0, 0), cB, voffB); PG8_STAGE(PG8_SB(0, 1), cB + hstep, voffB); PG8_STAGE(PG8_SA(0, 0), cA, voffA); PG8_STAGE(PG8_SA(0, 1), cA + hstep, voffA);
        if (wr == 1) PG8_BAR;
        PG8_WAIT_V(2); PG8_BAR;
        PG8_STAGE(PG8_SB(1, 0), cB + kstep, voffB); PG8_STAGE(PG8_SA(1, 0), cA + kstep, voffA); PG8_STAGE(PG8_SB(1, 1), cB + hstep + kstep, voffB);
        PG8_WAIT_V(6); PG8_BAR;
    } else {
        PG8_STAGE(PG8_SB(0, 0), cB, voffB); PG8_STAGE(PG8_SA(0, 0), cA, voffA); PG8_STAGE(PG8_SB(0, 1), cB + hstep, voffB); PG8_STAGE(PG8_SA(0, 1), cA + hstep, voffA);
        if (wr == 1) PG8_BAR;
        PG8_WAIT_V(4); PG8_BAR;
        PG8_STAGE(PG8_SB(1, 0), cB + kstep, voffB); PG8_STAGE(PG8_SA(1, 0), cA + kstep, voffA); PG8_STAGE(PG8_SB(1, 1), cB + hstep + kstep, voffB);
        PG8_WAIT_V(6); PG8_BAR;
    }
    for (;;) {
        const bool has_next = S.next(ui + 1, nxt);
        const char* nA = has_next ? (const char*)g.A + (size_t)nxt.pm * tstep : cA; const char* nB = has_next ? (const char*)g.Bt + (size_t)nxt.pn * tstep : cB;
        for (int t = 0; t < nt; t += 2) {
            const bool last = (t == nt - 2);
            const char* a1 = cA + (size_t)(t + 1) * kstep;
            const char* a2 = last ? nA : cA + (size_t)(t + 2) * kstep; const char* b2 = last ? nB : cB + (size_t)(t + 2) * kstep;
            const char* a3 = a2 + kstep; const char* b3 = b2 + kstep;
            if (last && has_next) S.a_ready(nxt);
            if constexpr (SP2) {
            PG8_LDB(B0, 0, 0); PG8_LDB(B1, 0, 1); PG8_SCHED; PG8_LDA(At, 0, 0); PG8_STAGE(PG8_SA(1, 1), a1 + hstep, voffA);
            PG8_WAIT_V(8); PG8_WAIT_L(0); PG8_BAR; PG8_MMA(0, 0, At, B0); PG8_MMA(0, 1, At, B1); PG8_BAR; PG8_SCHED;
            PG8_LDA(At, 0, 1); PG8_STAGE(PG8_SB(0, 0), b2, voffB); PG8_STAGE(PG8_SB(0, 1), b2 + hstep, voffB); PG8_STAGE(PG8_SA(0, 0), a2, voffA);
            PG8_WAIT_V(8); PG8_WAIT_L(0); PG8_BAR; PG8_MMA(1, 0, At, B0); PG8_MMA(1, 1, At, B1); PG8_BAR; PG8_SCHED;
            PG8_LDB(B0, 1, 0); PG8_LDB(B1, 1, 1); PG8_SCHED; PG8_LDA(At, 1, 0); PG8_STAGE(PG8_SA(0, 1), a2 + hstep, voffA);
            PG8_WAIT_V(8); PG8_WAIT_L(0); PG8_BAR; PG8_MMA(0, 0, At, B0); PG8_MMA(0, 1, At, B1); PG8_BAR; PG8_SCHED;
            PG8_LDA(At, 1, 1); PG8_STAGE(PG8_SB(1, 0), b3, voffB); PG8_STAGE(PG8_SB(1, 1), b3 + hstep, voffB); PG8_STAGE(PG8_SA(1, 0), a3, voffA);
            PG8_WAIT_V(8); PG8_WAIT_L(0); PG8_BAR; PG8_MMA(1, 0, At, B0); PG8_MMA(1, 1, At, B1); PG8_BAR; PG8_SCHED;
            if constexpr (Epi::KSCALE) { if (((t + 2) & 7) == 0) E.kscale(acc, cur, (t + 2) >> 3, wr, fr); }
            } else {
            PG8_LDB(B0, 0, 0); PG8_SCHED; PG8_LDA(At, 0, 0); PG8_STAGE(PG8_SA(1, 1), a1 + hstep, voffA);
            PG8_WAIT_L(8); PG8_BAR; PG8_WAIT_L(0); PG8_MMA(0, 0, At, B0); PG8_BAR; PG8_SCHED;
            PG8_LDB(B1, 0, 1); PG8_STAGE(PG8_SB(0, 0), b2, voffB);
            PG8_BAR; PG8_WAIT_L(0); PG8_MMA(0, 1, At, B1); PG8_BAR;
            PG8_LDA(At, 0, 1); PG8_STAGE(PG8_SA(0, 0), a2, voffA);
            PG8_BAR; PG8_WAIT_L(0); PG8_MMA(1, 0, At, B0); PG8_BAR; PG8_SCHED;
            PG8_STAGE(PG8_SB(0, 1), b2 + hstep, voffB);
            PG8_WAIT_V(6); PG8_BAR; PG8_MMA(1, 1, At, B1); PG8_BAR;
            PG8_LDB(B0, 1, 0); PG8_SCHED; PG8_LDA(At, 1, 0); PG8_STAGE(PG8_SA(0, 1), a2 + hstep, voffA);
            PG8_WAIT_L(8); PG8_BAR; PG8_WAIT_L(0); PG8_MMA(0, 0, At, B0); PG8_BAR; PG8_SCHED;
            PG8_LDB(B1, 1, 1); PG8_STAGE(PG8_SB(1, 0), b3, voffB);
            PG8_BAR; PG8_WAIT_L(0); PG8_MMA(0, 1, At, B1); PG8_BAR;
            PG8_LDA(At, 1, 1); PG8_STAGE(PG8_SA(1, 0), a3, voffA);
            PG8_BAR; PG8_WAIT_L(0); PG8_MMA(1, 0, At, B0); PG8_BAR; PG8_SCHED;
            PG8_STAGE(PG8_SB(1, 1), b3 + hstep, voffB);
            PG8_WAIT_V(6); PG8_BAR; PG8_MMA(1, 1, At, B1); PG8_BAR;
            }
        }
        if constexpr (ALIGN_EPI) { if (wr == 0) PG8_BAR; }
        if constexpr (!Epi::AFTER_DRAIN) { E(acc, cur, wr, wc, fr, fq); S.done(cur); }
        if (!has_next) break;
#pragma unroll
        for (int a = 0; a < 2; ++a)
#pragma unroll
            for (int b = 0; b < 2; ++b)
#pragma unroll
                for (int m = 0; m < 4; ++m)
#pragma unroll
                    for (int n = 0; n < 2; ++n) acc[a][b][m][n] = (f32x4){0.f, 0.f, 0.f, 0.f};
        cur = nxt; cA = nA; cB = nB; ++ui;
        if constexpr (ALIGN_EPI) { if (wr == 1) PG8_BAR; }
    }
    PG8_WAIT_V(0);
    if constexpr (!ALIGN_EPI) { if (wr == 0) PG8_BAR; }
    PG8_BAR;
    if constexpr (Epi::AFTER_DRAIN) { E.fused(acc, cur, wr, wc, fr, fq, lds, wid, lane); S.done(cur); }
#undef PG8_SA
#undef PG8_SB
#undef PG8_STAGE
#undef PG8_LDA
#undef PG8_LDB
#undef PG8_MMA
#undef PG8_WAIT_V
#undef PG8_WAIT_L
#undef PG8_BAR
#undef PG8_SCHED
}
}

constexpr int NWAVES = 8;
constexpr int D = 1024, FF = 2816, NUP = 2 * FF;
constexpr int MP = 8 * 2048, MS = 128 * 4, M = MP + MS;
constexpr int NSEQ_P = 8, TP = 2048, NSEQ_S = 128, TS = 4;
constexpr int R_H = 4, R_DK = 256, R_DV = 512, R_QK = 1024, R_V = 2048, R_NIN = 6144;
constexpr int G_H = 8, G_DK = 128, G_DV = 128, G_NIN = 4096;
constexpr int R_C = 64, G_C = 16;
constexpr float EPS = 1e-6f;
constexpr int NPHASE = 34;

constexpr size_t MiB = 1u << 20;
constexpr size_t WS_CTL = 0, CTL_ZERO_BYTES = 65536;
constexpr int CW_TMO = 0, CW_CODE = 1, CW_BAR = 1024;
constexpr size_t WS_ROPE = 1 * MiB;
constexpr size_t WS_TAB2 = 3 * MiB + 512 * 1024;
constexpr size_t WS_W = 4 * MiB;
constexpr size_t W_FFN_STRIDE = 16 * MiB + 512 * 1024, W_DOWN_OFF = 11 * MiB;
constexpr size_t W_RET_BASE = 132 * MiB, W_RET_STRIDE = 16 * MiB, W_ROUT_OFF = 12 * MiB;
constexpr size_t W_HG_BASE = 164 * MiB, W_HG_STRIDE = 10 * MiB, W_HOUT_OFF = 8 * MiB;
constexpr size_t WS_X = 192 * MiB, WS_XB = 258 * MiB, WS_HID = 291 * MiB, WS_QB = 382 * MiB, WS_KB = 415 * MiB, WS_VB = 448 * MiB, WS_GB = 514 * MiB,
                 WS_OF = 580 * MiB, WS_OB = 712 * MiB, WS_EB = 778 * MiB, WS_SSQ = 784 * MiB, WS_SSQO = 800 * MiB, WS_RT8 = 805 * MiB, WS_END = 806 * MiB;
constexpr int SSQ_SLOTS = 16;
static_assert(WS_SSQ + 13 * (size_t)M * SSQ_SLOTS * 4 <= WS_END, "ssq region");
static_assert(WS_X + (size_t)M * D * 4 <= WS_XB && WS_XB + (size_t)M * D * 2 <= WS_HID && WS_HID + (size_t)M * FF * 2 <= WS_QB && WS_OF + (size_t)M * R_V * 4 <= WS_OB, "ws map");

constexpr int RING_OFF = 0, RING_BYTES = 162816;
constexpr int LDSCTL_OFF = RING_BYTES, MISC_OFF = LDSCTL_OFF + 320;
constexpr int LDS_BYTES = 163840;

#define GAS __attribute__((address_space(1)))
#define LAS __attribute__((address_space(3)))
typedef unsigned short bf16;
typedef unsigned v4u __attribute__((ext_vector_type(4)));
typedef unsigned v2u __attribute__((ext_vector_type(2)));
typedef float f32x4 __attribute__((ext_vector_type(4)));
typedef GAS unsigned gu32;
#define RLX_AGENT __ATOMIC_RELAXED, __HIP_MEMORY_SCOPE_AGENT
#define LDS_WAIT() asm volatile("s_waitcnt lgkmcnt(0)" ::: "memory")
#define VM_WAIT() asm volatile("s_waitcnt vmcnt(0)" ::: "memory")
__device__ __forceinline__ unsigned f2bf(float f) { unsigned u = __builtin_bit_cast(unsigned, f); return (u + 0x7fffu + ((u >> 16) & 1u)) >> 16; }
__device__ __forceinline__ unsigned pk2(float lo, float hi) { return f2bf(lo) | (f2bf(hi) << 16); }
__device__ __forceinline__ float bf2f(unsigned short b) { return __builtin_bit_cast(float, (unsigned)b << 16); }
__device__ __forceinline__ float bflo(unsigned w) { return __builtin_bit_cast(float, w << 16); }
__device__ __forceinline__ float bfhi(unsigned w) { return __builtin_bit_cast(float, w & 0xffff0000u); }
__device__ __forceinline__ float fast_sigmoid(float x) { return __builtin_amdgcn_rcpf(1.0f + __expf(-x)); }
__device__ __forceinline__ float fast_silu(float x) { return x * fast_sigmoid(x); }
__device__ __forceinline__ float wave_sum(float v) {
#pragma unroll
    for (int o = 1; o < 64; o <<= 1) v += __shfl_xor(v, o);
    return v;
}
__device__ __forceinline__ int pos_index(int row) { return row < MP ? (row & (TP - 1)) : TP + (row & 3); }
__device__ __forceinline__ int ret_tprime(int row) { return row < MP ? (row & (R_C - 1)) : (row & 3); }

#define XB_TMO      128
#define XB_XCNT(j)  (256  + 64 * (j))
#define XB_XSUB(j)  (1280 + 64 * (j))
#define XB_XGEN(j)  (2304 + 64 * (j))
#define XB_TOP      3328
#define XB_TOPGEN   3392
#define XCD_BAR_WORDS 3456
#define XB_SPIN_CAP (1u << 18)

__device__ __forceinline__ unsigned xb_ld(unsigned* p)              { return __hip_atomic_load(p, __ATOMIC_RELAXED, __HIP_MEMORY_SCOPE_AGENT); }
__device__ __forceinline__ unsigned xb_add(unsigned* p, unsigned v) { return __hip_atomic_fetch_add(p, v, __ATOMIC_RELAXED, __HIP_MEMORY_SCOPE_AGENT); }
__device__ __forceinline__ unsigned xb_xcc_id() { return (unsigned)__builtin_amdgcn_s_getreg((3 << 11) | 20) & 0xFu; }
#define XB_SPIN(cond, bar) do { unsigned _sp = 0; while (cond) { __builtin_amdgcn_s_sleep(1); \
    if ((++_sp & 255u) == 0u) { if (xb_ld(&(bar)[XB_TMO])) break; if (_sp > XB_SPIN_CAP) { atomicAdd(&(bar)[XB_TMO], 1u); break; } } } } while (0)

struct XcdBarrier {
    unsigned* bar; unsigned x;
    volatile LAS unsigned* st;
};

__device__ __forceinline__ XcdBarrier xcd_barrier_post(unsigned* bar, volatile LAS unsigned* st) {
    XcdBarrier b; b.bar = bar; b.x = xb_xcc_id(); b.st = st;
    if (threadIdx.x == 0) (void)xb_add(&bar[XB_XCNT(b.x)], 1u);
    return b;
}
__device__ __forceinline__ void xcd_barrier_complete(unsigned* bar, unsigned x, unsigned& nloc, unsigned& nx) {
    const unsigned G = gridDim.x * gridDim.y * gridDim.z;
    unsigned sum, cnt, mine, sp = 0u;
    for (;;) {
        sum = 0u; cnt = 0u; mine = 0u;
#pragma unroll
        for (unsigned j = 0; j < 16; ++j) { const unsigned c = xb_ld(&bar[XB_XCNT(j)]); sum += c; cnt += (c > 0u) ? 1u : 0u; mine = (j == x) ? c : mine; }
        if (sum == G) break;
        __builtin_amdgcn_s_sleep(1);
        if ((++sp & 255u) == 0u) { if (xb_ld(&bar[XB_TMO])) break; if (sp > XB_SPIN_CAP) { atomicAdd(&bar[XB_TMO], 1u); break; } }
    }
    nloc = mine > 0u ? mine : 1u; nx = cnt > 0u ? cnt : 1u;
}

__device__ __forceinline__ void xcd_barrier(const XcdBarrier& b) {
    asm volatile("s_waitcnt vmcnt(0)" ::: "memory");
    __syncthreads();
    if (threadIdx.x == 0) {
        unsigned* bar = b.bar;
        __builtin_amdgcn_s_waitcnt(0);
        unsigned nloc = b.st[0], nx = b.st[1];
        if (nloc == 0u) { xcd_barrier_complete(bar, b.x, nloc, nx); b.st[0] = nloc; b.st[1] = nx; }
        const unsigned old = xb_add(&bar[XB_XSUB(b.x)], 1u);
        const unsigned gen = old / nloc;
        if (old + 1u == (gen + 1u) * nloc) {
            __builtin_amdgcn_fence(__ATOMIC_RELEASE, "agent");
            asm volatile("s_waitcnt vmcnt(0)" ::: "memory");
            const unsigned og = xb_add(&bar[XB_TOP], 1u);
            const unsigned tg = og / nx;
            if (og + 1u == (tg + 1u) * nx) xb_add(&bar[XB_TOPGEN], 1u);
            else XB_SPIN(xb_ld(&bar[XB_TOPGEN]) == tg, bar);
            __builtin_amdgcn_fence(__ATOMIC_ACQUIRE, "agent");
            xb_add(&bar[XB_XGEN(b.x)], 1u);
            asm volatile("s_waitcnt vmcnt(0)" ::: "memory");
        } else {
            XB_SPIN(xb_ld(&bar[XB_XGEN(b.x)]) == gen, bar);
            __builtin_amdgcn_fence(__ATOMIC_ACQUIRE, "agent");
            asm volatile("s_waitcnt vmcnt(0)" ::: "memory");
        }
    }
    __syncthreads();
}

typedef GAS float gf32; typedef GAS bf16 gbf16; typedef GAS pg8::u32x4 gu32x4; typedef GAS pg8::f32x4 gf32x4; typedef GAS v4u gv4u;
__device__ __forceinline__ pg8::u32x4 pack8(const float (&h)[8]) {
    pg8::u32x4 w; w.x = pg8::cvt_pk_bf16(h[0], h[1]); w.y = pg8::cvt_pk_bf16(h[2], h[3]); w.z = pg8::cvt_pk_bf16(h[4], h[5]); w.w = pg8::cvt_pk_bf16(h[6], h[7]); return w;
}
__device__ __forceinline__ float row_rstd(const gf32* ssq, int row) {
    const gf32x4* p = (const gf32x4*)(ssq + (size_t)row * SSQ_SLOTS); const pg8::f32x4 a = p[0], b = p[1], c = p[2], d = p[3];
    const float s = (((a[0] + a[1]) + (a[2] + a[3])) + ((b[0] + b[1]) + (b[2] + b[3]))) + (((c[0] + c[1]) + (c[2] + c[3])) + ((d[0] + d[1]) + (d[2] + d[3])));
    return rsqrtf(s * (1.0f / D) + EPS);
}
constexpr int LRS_OFF = 131072 + 4096;
static_assert(LRS_OFF + 7 * 1024 <= RING_BYTES, "rstd staging");
template <class Sched> __device__ __forceinline__ const LAS float* stage_row_rstd(LAS unsigned char* lds, const Sched& S, const gf32* ssq, int tid) {
    LAS float* lrs = (LAS float*)(lds + LRS_OFF);
    asm volatile("" : "+v"(tid));
    if (tid < 256) { pg8::Unit u; for (int i = 0; S.next(i, u); ++i) lrs[i * 256 + tid] = row_rstd(ssq, u.pm * 256 + tid); }
    LDS_WAIT(); __syncthreads();
    return lrs;
}

struct EpiUp {
    static constexpr bool PERM = true, AFTER_DRAIN = false, KSCALE = false;
    gbf16* H; const LAS float* lrs;
    __device__ __forceinline__ void operator()(const pg8::f32x4 (&acc)[2][2][4][2], const pg8::Unit& u, int wr, int wc, int fr, int fq) const {
        const int row0 = u.pm * 256 + wr * 64 + fr, col0 = u.pn * 128 + wc * 32 + 8 * fq;
#pragma unroll
        for (int ai = 0; ai < 2; ++ai)
#pragma unroll
            for (int m = 0; m < 4; ++m) {
                const int row = row0 + ai * 128 + m * 16;
                const float rs = lrs[u.ord * 256 + (row - u.pm * 256)];
                typedef float f32x2 __attribute__((ext_vector_type(2)));
                const float k1s = rs * -1.4426950408889634f, cs = __builtin_amdgcn_rcpf(rs * rs);
                const f32x2 k1 = (f32x2){k1s, k1s}, c2 = (f32x2){cs, cs};
                float h[8];
#pragma unroll
                for (int n = 0; n < 2; ++n)
#pragma unroll
                    for (int p = 0; p < 2; ++p) {
                        const f32x2 a = (f32x2){acc[ai][0][m][n][2 * p], acc[ai][0][m][n][2 * p + 1]}, b = (f32x2){acc[ai][1][m][n][2 * p], acc[ai][1][m][n][2 * p + 1]};
                        const f32x2 t = a * k1;
                        const f32x2 d = __builtin_elementwise_fma((f32x2){__builtin_amdgcn_exp2f(t.x), __builtin_amdgcn_exp2f(t.y)}, c2, c2);
                        const f32x2 r = (f32x2){__builtin_amdgcn_rcpf(d.x), __builtin_amdgcn_rcpf(d.y)};
                        const f32x2 hh = (a * b) * r;
                        h[4 * n + 2 * p] = hh.x; h[4 * n + 2 * p + 1] = hh.y;
                    }
                *(gu32x4*)(H + (size_t)row * FF + col0) = pack8(h);
            }
    }
};
struct EpiRes {
    static constexpr bool PERM = true, AFTER_DRAIN = false, KSCALE = false;
    gbf16* xb; gf32* ssq_out; float scale;
    __device__ __forceinline__ void operator()(const pg8::f32x4 (&acc)[2][2][4][2], const pg8::Unit& u, int wr, int wc, int fr, int fq) const {
        const int row0 = u.pm * 256 + wr * 64 + fr, col0 = u.pn * 256 + wc * 32 + 8 * fq;
#pragma unroll
        for (int ai = 0; ai < 2; ++ai) {
            pg8::u32x4 xh[4][2];
#pragma unroll
            for (int mm = 0; mm < 4; ++mm)
#pragma unroll
                for (int bj = 0; bj < 2; ++bj) {
                    const size_t off = (size_t)(row0 + ai * 128 + mm * 16) * D + col0 + bj * 128;
                    xh[mm][bj] = *(const gu32x4*)(xb + off);
                }
#pragma unroll
            for (int mm = 0; mm < 4; ++mm) {
                const int m = mm;
                const int row = row0 + ai * 128 + m * 16;
                float ss = 0.f;
#pragma unroll
                for (int bj = 0; bj < 2; ++bj) {
                    const size_t off = (size_t)row * D + col0 + bj * 128;
                    float h[8];
#pragma unroll
                    for (int q = 0; q < 4; ++q) {
                        h[2 * q] = bflo(xh[mm][bj][q]) + acc[ai][bj][m][q >> 1][2 * (q & 1)] * scale;
                        h[2 * q + 1] = bfhi(xh[mm][bj][q]) + acc[ai][bj][m][q >> 1][2 * (q & 1) + 1] * scale;
                    }
                    const pg8::u32x4 hn = pack8(h);
                    *(gu32x4*)(xb + off) = hn;
                    ss += ((h[0] * h[0] + h[1] * h[1]) + (h[2] * h[2] + h[3] * h[3])) + ((h[4] * h[4] + h[5] * h[5]) + (h[6] * h[6] + h[7] * h[7]));
                }
                ss += __shfl_xor(ss, 16); ss += __shfl_xor(ss, 32);
                if (fq == 0) ssq_out[(size_t)row * SSQ_SLOTS + u.pn * 4 + wc] = ss;
            }
            asm volatile("" ::: "memory");
        }
    }
};
struct EpiResKS : EpiRes {
    static constexpr bool KSCALE = true;
    LAS unsigned char* lfac;
    __device__ __forceinline__ void kscale(pg8::f32x4 (&acc)[2][2][4][2], const pg8::Unit& u, int hb, int wr, int fr) const {
        int fr_ = fr; asm volatile("" : "+v"(fr_));
        const int lrow0 = wr * 64 + fr_;
#pragma unroll
        for (int ai = 0; ai < 2; ++ai)
#pragma unroll
            for (int m = 0; m < 4; ++m) {
                const float s = *(const LAS float*)(lfac + ((lrow0 + ai * 128 + m * 16) * 4 + hb - 1) * 4);
#pragma unroll
                for (int bj = 0; bj < 2; ++bj)
#pragma unroll
                    for (int n = 0; n < 2; ++n) acc[ai][bj][m][n] = acc[ai][bj][m][n] * s;
            }
    }
};
struct EpiRetIn {
    static constexpr bool PERM = true, AFTER_DRAIN = false, KSCALE = false;
    gbf16 *Q, *K, *V, *G; const LAS float* lrs; const gf32* rope; const gf32* gq; const gf32* gk;
    __device__ __forceinline__ void operator()(const pg8::f32x4 (&acc)[2][2][4][2], const pg8::Unit& u, int wr, int wc, int fr, int fq) const {
        const int row0 = u.pm * 256 + wr * 64 + fr, cl = wc * 32 + 8 * fq, pn = u.pn;
        if (pn < 8) {
            const bool isq = pn < 4; const int h = pn & 3; gbf16* dst = isq ? Q : K; const gf32* gt = (isq ? gq : gk) + h * 128; const float ksc = isq ? 1.0f : 0.0625f;
#pragma unroll
            for (int am = 0; am < 4; ++am) {
                const int ai = am >> 1;
                pg8::f32x4 cs[2][4]; float gv[2];
#pragma unroll
                for (int mm = 0; mm < 2; ++mm) {
                    const int row = row0 + ai * 128 + (2 * (am & 1) + mm) * 16;
                    const gf32x4* rp = (const gf32x4*)(rope + ((size_t)pos_index(row) * 128 + cl) * 2);
                    gv[mm] = gt[ret_tprime(row)];
#pragma unroll
                    for (int q = 0; q < 4; ++q) cs[mm][q] = rp[q];
                }
#pragma unroll
                for (int mm = 0; mm < 2; ++mm) {
                    const int m = 2 * (am & 1) + mm;
                    const int row = row0 + ai * 128 + m * 16;
                    const float dec = lrs[u.ord * 256 + (row - u.pm * 256)] * gv[mm] * ksc;
                    float o1[8], o2[8];
#pragma unroll
                    for (int n = 0; n < 2; ++n) {
                        const pg8::f32x4 cs0 = cs[mm][2 * n], cs1 = cs[mm][2 * n + 1];
                        const float c[4] = {cs0[0], cs0[2], cs1[0], cs1[2]}, s[4] = {cs0[1], cs0[3], cs1[1], cs1[3]};
#pragma unroll
                        for (int i = 0; i < 4; ++i) { const float x1 = acc[ai][0][m][n][i], x2 = acc[ai][1][m][n][i];
                            o1[4 * n + i] = (x1 * c[i] - x2 * s[i]) * dec; o2[4 * n + i] = (x1 * s[i] + x2 * c[i]) * dec; }
                    }
                    gbf16* p = dst + (size_t)row * R_QK + h * R_DK + cl;
                    *(gu32x4*)p = pack8(o1); *(gu32x4*)(p + 128) = pack8(o2);
                }
            }
        } else {
            const bool isv = pn < 16; gbf16* dst = isv ? V : G; const int cb = (isv ? pn - 8 : pn - 16) * 256 + cl;
#pragma unroll
            for (int ai = 0; ai < 2; ++ai)
#pragma unroll
                for (int m = 0; m < 4; ++m) {
                    const int row = row0 + ai * 128 + m * 16;
                    const float rs = lrs[u.ord * 256 + (row - u.pm * 256)];
#pragma unroll
                    for (int bj = 0; bj < 2; ++bj) {
                        float h[8];
#pragma unroll
                        for (int n = 0; n < 2; ++n)
#pragma unroll
                            for (int i = 0; i < 4; ++i) { const float v = acc[ai][bj][m][n][i] * rs; h[4 * n + i] = isv ? v : fast_silu(v); }
                        *(gu32x4*)(dst + (size_t)row * R_V + cb + bj * 128) = pack8(h);
                    }
                }
        }
    }
};
template <int SH> __device__ __forceinline__ float dpp_row_shr(float v) { return __builtin_bit_cast(float, __builtin_amdgcn_update_dpp(0, __builtin_bit_cast(int, v), 0x110 + SH, 0xf, 0xf, false)); }
struct EpiHgIn {
    static constexpr bool PERM = true, AFTER_DRAIN = false, KSCALE = false;
    gbf16 *Qb, *Kt, *V, *G; gf32* EB; const LAS float* lrs; const gf32* lb;
    __device__ __forceinline__ void operator()(const pg8::f32x4 (&acc)[2][2][4][2], const pg8::Unit& u, int wr, int wc, int fr, int fq) const {
        const int row0 = u.pm * 256 + wr * 64 + fr, cl = wc * 32 + 8 * fq, pn = u.pn;
        if (pn < 8) {
            const int cb = pn * 128 + cl; const bool samp = u.pm >= MP / 256; const int fl = samp ? (fr & 3) : fr, flast = samp ? 3 : 15;
            float lbv[8];
#pragma unroll
            for (int j = 0; j < 8; ++j) lbv[j] = lb[cb + j];
#pragma unroll
            for (int ai = 0; ai < 2; ++ai)
#pragma unroll
                for (int m = 0; m < 4; ++m) {
                    const int row = row0 + ai * 128 + m * 16;
                    const float rs = lrs[u.ord * 256 + (row - u.pm * 256)];
                    float qo[8], ko[8], eb[8];
#pragma unroll
                    for (int n = 0; n < 2; ++n)
#pragma unroll
                        for (int i = 0; i < 4; ++i) {
                            const int j = 4 * n + i;
                            const float qv = acc[ai][0][m][n][i] * rs, zv = acc[ai][1][m][n][i] * rs;
                            const float ez = __expf(-zv), s = __builtin_amdgcn_rcpf(1.0f + ez), sm = ez * s;
                            const float oml = 1.0f - lbv[j];
                            const float f = lbv[j] + oml * s, kk = oml * sm;
                            float e = f, t;
                            t = dpp_row_shr<1>(e); e *= fl >= 1 ? t : 1.f;
                            t = dpp_row_shr<2>(e); e *= fl >= 2 ? t : 1.f;
                            t = dpp_row_shr<4>(e); e *= fl >= 4 ? t : 1.f;
                            t = dpp_row_shr<8>(e); e *= fl >= 8 ? t : 1.f;
                            qo[j] = fast_silu(qv) * e; ko[j] = kk * __builtin_amdgcn_rcpf(e); eb[j] = e;
                        }
                    *(gu32x4*)(Qb + (size_t)row * D + cb) = pack8(qo);
                    *(gu32x4*)(Kt + (size_t)row * D + cb) = pack8(ko);
                    if (fl == flast) { const int chunk = samp ? 1024 + ((row - MP) >> 2) : (row >> 4); gf32* ep = EB + (size_t)chunk * D + cb;
                        *(gf32x4*)ep = (pg8::f32x4){eb[0], eb[1], eb[2], eb[3]}; *(gf32x4*)(ep + 4) = (pg8::f32x4){eb[4], eb[5], eb[6], eb[7]}; }
                }
        } else {
            const bool isv = pn < 12; gbf16* dst = isv ? V : G; const int cb = (isv ? pn - 8 : pn - 12) * 256 + cl;
#pragma unroll
            for (int ai = 0; ai < 2; ++ai)
#pragma unroll
                for (int m = 0; m < 4; ++m) {
                    const int row = row0 + ai * 128 + m * 16;
                    const float rs = lrs[u.ord * 256 + (row - u.pm * 256)];
#pragma unroll
                    for (int bj = 0; bj < 2; ++bj) {
                        float h[8];
#pragma unroll
                        for (int n = 0; n < 2; ++n)
#pragma unroll
                            for (int i = 0; i < 4; ++i) { const float v = acc[ai][bj][m][n][i] * rs; h[4 * n + i] = isv ? v : fast_silu(v); }
                        *(gu32x4*)(dst + (size_t)row * D + cb + bj * 128) = pack8(h);
                    }
                }
        }
    }
};

struct Frame {
    LAS unsigned char* lds;
    volatile LAS unsigned* MISC;
    gu32* ctl;
    int tid, lane, wave, G;
};

__device__ __forceinline__ void transpose_item(const gf32* W, int N, const gf32* kscale, gbf16* WT, int K, int k0, int n0, int dst_row0, LAS float* scr, int lane) {
    float wv[32];
#pragma unroll
    for (int i = 0; i < 32; ++i) wv[i] = W[(size_t)(k0 + 2 * i + (lane >> 5)) * N + n0 + (lane & 31)];
#pragma unroll
    for (int i = 0; i < 32; ++i) { const int kk = 2 * i + (lane >> 5); const float sc = kscale ? kscale[k0 + kk] : 1.0f; scr[kk * 33 + (lane & 31)] = wv[i] * sc; }
    LDS_WAIT(); asm volatile("" ::: "memory");
    const int c = lane & 7;
#pragma unroll
    for (int j = 0; j < 4; ++j) { const int n = (lane >> 3) + 8 * j; const LAS float* s = scr + (8 * c) * 33 + n;
        v4u o; o.x = pk2(s[0 * 33], s[1 * 33]); o.y = pk2(s[2 * 33], s[3 * 33]); o.z = pk2(s[4 * 33], s[5 * 33]); o.w = pk2(s[6 * 33], s[7 * 33]);
        *(GAS v4u*)(WT + (size_t)(dst_row0 + n) * K + k0 + 8 * c) = o; }
    LDS_WAIT(); asm volatile("" ::: "memory");
}
__device__ __forceinline__ int pair_row(int c, int half_cols) {
    return c < half_cols ? 256 * (c >> 7) + (c & 127) : 256 * ((c - half_cols) >> 7) + 128 + ((c - half_cols) & 127);
}
__device__ __forceinline__ double dpow_int(double base, int e) { double r = 1.0, b = base; while (e > 0) { if (e & 1) r *= b; b *= b; e >>= 1; } return r; }
__device__ __forceinline__ void sincos_reduced(double ang, float& c, float& s) {
    const double k = __builtin_rint(ang * 0.6366197723675814);
    double y = __builtin_fma(-k, 1.5707963267948966, ang); y = __builtin_fma(-k, 6.123233995736766e-17, y);
    const double y2 = y * y;
    double sp = -1.0 / 39916800.0; sp = sp * y2 + 1.0 / 362880.0; sp = sp * y2 - 1.0 / 5040.0; sp = sp * y2 + 1.0 / 120.0; sp = sp * y2 - 1.0 / 6.0; sp = sp * y2 * y + y;
    double cp = 1.0 / 479001600.0; cp = cp * y2 - 1.0 / 3628800.0; cp = cp * y2 + 1.0 / 40320.0; cp = cp * y2 - 1.0 / 720.0; cp = cp * y2 + 1.0 / 24.0; cp = cp * y2 - 0.5; cp = cp * y2 + 1.0;
    const int q = ((int)k) & 3;
    const double cc = (q == 0) ? cp : (q == 1) ? -sp : (q == 2) ? -cp : sp;
    const double ssn = (q == 0) ? sp : (q == 1) ? cp : (q == 2) ? -sp : -cp;
    c = (float)cc; s = (float)ssn;
}
struct PrologueArgs { const gf32 *xp, *xs, *norm_gain, *w_up, *w_down, *ret_w_in, *ret_norm, *ret_w_out, *hg_w_in, *hg_lb, *hg_norm, *hg_w_out; GAS unsigned char* ws; };

__device__ __forceinline__ void convert_layer_weights(Frame& F, const PrologueArgs& A, int layer, int q0, int q1, int wid, int nw) {
    LAS float* scr = (LAS float*)(F.lds + RING_OFF + F.wave * 16384);
    GAS unsigned char* ws = A.ws;
    constexpr int I_UP = 16 * 176, I_DN = 44 * 32, I_RIN = 16 * 192, I_ROUT = 32 * 32, I_HIN = 16 * 128, I_HOUT = 16 * 32;
    const bool isret = (layer & 1) == 0; const int j = layer >> 1;
    const int NL = 2 * I_UP + 2 * I_DN + (isret ? I_RIN + I_ROUT : I_HIN + I_HOUT);
    const int lo = (int)((long)NL * q0 / 4), hi = (int)((long)NL * q1 / 4);
    for (int it = lo + wid; it < hi; it += nw) {
        int r = it;
        if (r < 2 * I_UP) { const int f = r / I_UP; r -= f * I_UP; const int idx = 2 * layer + f, kb = r / 176, nb = r % 176;
            transpose_item(A.w_up + (size_t)idx * D * NUP, NUP, A.norm_gain + (layer * 3 + (f ? 2 : 0)) * D, (gbf16*)(ws + WS_W + idx * W_FFN_STRIDE), D, 64 * kb, 32 * nb, pair_row(32 * nb, FF), scr, F.lane); continue; }
        r -= 2 * I_UP;
        if (r < 2 * I_DN) { const int f = r / I_DN; r -= f * I_DN; const int idx = 2 * layer + f, kb = r / 32, nb = r % 32;
            transpose_item(A.w_down + (size_t)idx * FF * D, D, nullptr, (gbf16*)(ws + WS_W + idx * W_FFN_STRIDE + W_DOWN_OFF), FF, 64 * kb, 32 * nb, 32 * nb, scr, F.lane); continue; }
        r -= 2 * I_DN;
        if (isret) {
            if (r < I_RIN) { const int kb = r / 192, nb = r % 192;
                transpose_item(A.ret_w_in + (size_t)j * D * R_NIN, R_NIN, A.norm_gain + (layer * 3 + 1) * D, (gbf16*)(ws + WS_W + W_RET_BASE + j * W_RET_STRIDE), D, 64 * kb, 32 * nb, 32 * nb, scr, F.lane); continue; }
            r -= I_RIN;
            { const int kb = r / 32, nb = r % 32;
                transpose_item(A.ret_w_out + (size_t)j * R_V * D, D, A.ret_norm + j * R_V, (gbf16*)(ws + WS_W + W_RET_BASE + j * W_RET_STRIDE + W_ROUT_OFF), R_V, 64 * kb, 32 * nb, 32 * nb, scr, F.lane); }
        } else {
            if (r < I_HIN) { const int kb = r / 128, nb = r % 128; const int n0 = 32 * nb;
                transpose_item(A.hg_w_in + (size_t)j * D * G_NIN, G_NIN, A.norm_gain + (layer * 3 + 1) * D, (gbf16*)(ws + WS_W + W_HG_BASE + j * W_HG_STRIDE), D, 64 * kb, n0, n0 < 2048 ? pair_row(n0, 1024) : n0, scr, F.lane); continue; }
            r -= I_HIN;
            { const int kb = r / 32, nb = r % 32;
                transpose_item(A.hg_w_out + (size_t)j * D * D, D, A.hg_norm + j * D, (gbf16*)(ws + WS_W + W_HG_BASE + j * W_HG_STRIDE + W_HOUT_OFF), D, 64 * kb, 32 * nb, 32 * nb, scr, F.lane); }
        }
    }
}
__device__ __forceinline__ void p0_prologue(Frame& F, const PrologueArgs& A) {
    LAS float* scr = (LAS float*)(F.lds + RING_OFF + F.wave * 16384);
    const int gw = blockIdx.x * NWAVES + F.wave, NGW = F.G * NWAVES;
    GAS unsigned char* ws = A.ws;
    {
        gbf16* XB = (gbf16*)(ws + WS_XB); gf32* ssq0 = (gf32*)(ws + WS_SSQ);
        for (int row = gw; row < M; row += NGW) {
            const gf32* src = row < MP ? A.xp + (size_t)row * D : A.xs + (size_t)(row - MP) * D;
            const GAS f32x4* xr = (const GAS f32x4*)src + F.lane;
            f32x4 v[4]; float s = 0.f;
#pragma unroll
            for (int j = 0; j < 4; ++j) { v[j] = xr[64 * j]; s += (v[j].x * v[j].x + v[j].y * v[j].y) + (v[j].z * v[j].z + v[j].w * v[j].w); }
            s = wave_sum(s);
            GAS v2u* bo = (GAS v2u*)(XB + (size_t)row * D) + F.lane;
#pragma unroll
            for (int j = 0; j < 4; ++j) { v2u w; w.x = pk2(v[j].x, v[j].y); w.y = pk2(v[j].z, v[j].w); bo[64 * j] = w; }
            if (F.lane < SSQ_SLOTS) ssq0[(size_t)row * SSQ_SLOTS + F.lane] = F.lane == 0 ? s : 0.f;
        }
    }
    {
        const int gt = blockIdx.x * (NWAVES * 64) + F.tid, NT = F.G * NWAVES * 64;
        gf32* rope = (gf32*)(ws + WS_ROPE); gf32* tab2 = (gf32*)(ws + WS_TAB2);
        for (int i = gt; i < (TP + TS) * 128; i += NT) {
            const int p = i >> 7, j = i & 127; const double pos = p < TP ? (double)p : (double)(16384 + (p - TP));
            const double inv = dpow_int(0.9305720409296989792906463, j);
            float c, s; sincos_reduced(pos * inv, c, s); rope[2 * i] = c; rope[2 * i + 1] = s;
        }
        for (int i = gt; i < 4 * 128; i += NT) {
            const int h = i >> 7, t = i & 127; const double gam = 1.0 - dpow_int(0.5, 5 + h), g = dpow_int(gam, t + 1);
            tab2[i] = (float)g; tab2[512 + i] = (float)(1.0 / g);
        }
        for (int i = gt; i < 8; i += NT) { const int h = i >> 1; const double gam = 1.0 - dpow_int(0.5, 5 + h); tab2[1024 + i] = (float)dpow_int(gam, (i & 1) ? 4 : R_C); }
        for (int i = gt; i < 2048; i += NT) { const int c = i & 1023; tab2[2048 + i] = (i < 1024) ? 0.0f : 1.0f / (1.0f + expf(A.hg_lb[c] - A.hg_lb[1024 + c])); }
    }
    convert_layer_weights(F, A, 0, 0, 4, gw, NGW);
}

template <int DK, int DV, int H, int CP>
__device__ __forceinline__ void rec_naive(Frame& F, const gbf16* Qh, const gbf16* Kt, const gbf16* V, const gf32* EB, const gf32* gC, const gf32* S0, gbf16* O  , gf32* SoutP, gf32* SoutS, int u0  , int bofs  ,
                                          const gbf16* Gt = nullptr  , gbf16* OBg = nullptr, gf32* SSQo = nullptr) {
    constexpr int EG = DV / 64, RD = DK / 8, NU = (NSEQ_P + NSEQ_S) * H * EG;
    LAS float* red = (LAS float*)(F.lds + RING_OFF);
    int vz; asm volatile("v_mov_b32 %0, 0" : "=v"(vz));
    if ((int)blockIdx.x >= bofs)
    for (int u = u0 + (int)blockIdx.x - bofs; u < NU; u += F.G - bofs) {
        const int seq = u / (H * EG), h = (u / EG) % H, eg = u % EG;
        const bool samp = seq >= NSEQ_P;
        const int T = samp ? TS : TP, C = samp ? 4 : CP;
        const int rowb = samp ? MP + (seq - NSEQ_P) * TS : seq * TP;
        const int d0 = F.wave * RD, e = eg * 64 + F.lane;
        float R[RD];
        if (samp) { const gf32* s0 = S0 + (((size_t)(seq - NSEQ_P) * H + h) * DK + d0) * DV + e;
#pragma unroll
            for (int i = 0; i < RD; ++i) R[i] = s0[(size_t)i * DV]; }
        else {
#pragma unroll
            for (int i = 0; i < RD; ++i) R[i] = 0.f; }
        const float gsc = gC ? gC[h * 2 + (samp ? 1 : 0)] : 1.0f;
        v4u kn[RD / 8], qn[RD / 8]; unsigned short vn;
        { const size_t ro = (size_t)rowb * (H * DK) + h * DK + d0 + vz;
#pragma unroll
          for (int c8 = 0; c8 < RD / 8; ++c8) { kn[c8] = ((const gv4u*)(Kt + ro))[c8]; qn[c8] = ((const gv4u*)(Qh + ro))[c8]; }
          vn = V[(size_t)rowb * (H * DV) + h * DV + e]; }
        for (int t0 = 0; t0 < T; t0 += 4) {
            const int buf = (t0 >> 2) & 1;
#pragma unroll 1
            for (int tt = 0; tt < 4; ++tt) {
                const int row = rowb + t0 + tt;
                v4u kc[RD / 8], qc[RD / 8];
#pragma unroll
                for (int c8 = 0; c8 < RD / 8; ++c8) { kc[c8] = kn[c8]; qc[c8] = qn[c8]; }
                const float v = bf2f(vn);
                { const int rown = (t0 + tt + 1 < T) ? row + 1 : row;
                  const size_t ro = (size_t)rown * (H * DK) + h * DK + d0 + vz;
#pragma unroll
                  for (int c8 = 0; c8 < RD / 8; ++c8) { kn[c8] = ((const gv4u*)(Kt + ro))[c8]; qn[c8] = ((const gv4u*)(Qh + ro))[c8]; }
                  vn = V[(size_t)rown * (H * DV) + h * DV + e]; }
                float p = 0.f;
#pragma unroll
                for (int c8 = 0; c8 < RD / 8; ++c8) {
                    const unsigned kk[4] = {kc[c8].x, kc[c8].y, kc[c8].z, kc[c8].w}, qq[4] = {qc[c8].x, qc[c8].y, qc[c8].z, qc[c8].w};
#pragma unroll
                    for (int w2 = 0; w2 < 4; ++w2) {
                        R[c8 * 8 + 2 * w2] += bflo(kk[w2]) * v; p += bflo(qq[w2]) * R[c8 * 8 + 2 * w2];
                        R[c8 * 8 + 2 * w2 + 1] += bfhi(kk[w2]) * v; p += bfhi(qq[w2]) * R[c8 * 8 + 2 * w2 + 1];
                    }
                }
                red[((buf * 4 + tt) * 8 + F.wave) * 64 + F.lane] = p;
                if (((t0 + tt + 1) % C) == 0) {
                    if (EB) { const int chunk = samp ? 1024 + ((row - MP) >> 2) : (row >> 4); const gf32* ep = EB + (size_t)chunk * (H * DK) + h * DK + d0 + vz;
#pragma unroll
                        for (int i = 0; i < RD; ++i) R[i] *= ep[i]; }
                    else {
#pragma unroll
                        for (int i = 0; i < RD; ++i) R[i] *= gsc; }
                }
            }
            LDS_WAIT(); __syncthreads();
            if (F.tid < 256) { const int tt = F.tid >> 6, l = F.tid & 63; float s = 0.f;
#pragma unroll
                for (int w = 0; w < 8; ++w) s += red[((buf * 4 + tt) * 8 + w) * 64 + l];
                const size_t oi = (size_t)(rowb + t0 + tt) * (H * DV) + h * DV + eg * 64 + l;
                if (Gt) { OBg[oi] = (bf16)f2bf(s * bf2f(Gt[oi])); const float ss = wave_sum(s * s); if (l == 0) SSQo[(size_t)(rowb + t0 + tt) * (H * EG) + h * EG + eg] = ss; }
                else O[oi] = (bf16)f2bf(s); }
        }
        gf32* so = samp ? SoutS + (((size_t)(seq - NSEQ_P) * H + h) * DK + d0) * DV + e : SoutP + (((size_t)seq * H + h) * DK + d0) * DV + e;
#pragma unroll
        for (int i = 0; i < RD; ++i) so[(size_t)i * DV] = R[i];
        LDS_WAIT(); __syncthreads();
    }
}

template <int DV>
__device__ __forceinline__ void headnorm_phase(Frame& F, const gbf16* O, const gbf16* Gt, gbf16* OB, int ntask  ) {
    constexpr int LPH = DV / 8;
    const int gw = blockIdx.x * NWAVES + F.wave, NGW = F.G * NWAVES;
    for (int t = gw; t < ntask; t += NGW) {
        const size_t base = (size_t)t * 512 + F.lane * 8;
        const v4u o8 = *(const gv4u*)(O + base);
        const f32x4 a = (f32x4){bflo(o8.x), bfhi(o8.x), bflo(o8.y), bfhi(o8.y)}, b = (f32x4){bflo(o8.z), bfhi(o8.z), bflo(o8.w), bfhi(o8.w)};
        const v4u g = *(const gv4u*)(Gt + base);
        float ss = (a.x * a.x + a.y * a.y) + (a.z * a.z + a.w * a.w) + (b.x * b.x + b.y * b.y) + (b.z * b.z + b.w * b.w);
#pragma unroll
        for (int o = 1; o < LPH; o <<= 1) ss += __shfl_xor(ss, o);
        const float rs = rsqrtf(ss * (1.0f / DV) + EPS);
        v4u w; w.x = pk2(a.x * rs * bflo(g.x), a.y * rs * bfhi(g.x)); w.y = pk2(a.z * rs * bflo(g.y), a.w * rs * bfhi(g.y));
        w.z = pk2(b.x * rs * bflo(g.z), b.y * rs * bfhi(g.z)); w.w = pk2(b.z * rs * bflo(g.w), b.w * rs * bfhi(g.w));
        *(gv4u*)(OB + base) = w;
    }
}
__device__ __forceinline__ float ret_head_rstd(const gf32* SSQo, int row, int h) {
    const GAS f32x4* p = (const GAS f32x4*)(SSQo + (size_t)row * 64 + h * 16); const f32x4 a = p[0], b = p[1], c4 = p[2], d4 = p[3];
    const float s = (((a.x + a.y) + (a.z + a.w)) + ((b.x + b.y) + (b.z + b.w))) + (((c4.x + c4.y) + (c4.z + c4.w)) + ((d4.x + d4.y) + (d4.z + d4.w)));
    return rsqrtf(s * (1.0f / R_DV) + EPS);
}
__device__ __forceinline__ void ret_rstd_phase(Frame& F, const gf32* SSQo, gf32* RT8) {
    for (int row = blockIdx.x * (NWAVES * 64) + F.tid; row < M; row += F.G * NWAVES * 64) {
        float r[4];
#pragma unroll
        for (int h = 0; h < 4; ++h) {
            const GAS f32x4* p = (const GAS f32x4*)(SSQo + (size_t)row * 64 + h * 16); const f32x4 a = p[0], b = p[1], c4 = p[2], d4 = p[3];
            const float s = (((a.x + a.y) + (a.z + a.w)) + ((b.x + b.y) + (b.z + b.w))) + (((c4.x + c4.y) + (c4.z + c4.w)) + ((d4.x + d4.y) + (d4.z + d4.w)));
            r[h] = rsqrtf(s * (1.0f / R_DV) + EPS);
        }
        *(GAS f32x4*)(RT8 + (size_t)row * 8) = (f32x4){r[0], r[1], r[2], r[3]};
        *(GAS f32x4*)(RT8 + (size_t)row * 8 + 4) = (f32x4){r[0] / r[1], r[1] / r[2], r[2] / r[3], r[3]};
    }
}
__device__ __forceinline__ void final_phase(Frame& F, const gbf16* XB, const gf32* ssq, const gf32* fn, gf32* out, float probe_scale  ) {
    const int gw = blockIdx.x * NWAVES + F.wave, NGW = F.G * NWAVES;
    for (int row = gw; row < M; row += NGW) {
        const float rs = row_rstd(ssq, row) * (row >= MP ? probe_scale : 1.0f);
        const GAS v2u* hr = (const GAS v2u*)(XB + (size_t)row * D) + F.lane;
        const GAS f32x4* gr = (const GAS f32x4*)fn + F.lane; GAS f32x4* yo = (GAS f32x4*)(out + (size_t)row * D) + F.lane;
#pragma unroll
        for (int j = 0; j < 4; ++j) { const v2u hh = hr[64 * j]; const f32x4 g = gr[64 * j];
            const f32x4 v = (f32x4){bflo(hh.x), bfhi(hh.x), bflo(hh.y), bfhi(hh.y)};
            yo[64 * j] = (f32x4){v.x * rs * g.x, v.y * rs * g.y, v.z * rs * g.z, v.w * rs * g.w}; }
    }
}

typedef float f32x16 __attribute__((ext_vector_type(16)));
typedef short s16x4 __attribute__((ext_vector_type(4)));
typedef short s16x8 __attribute__((ext_vector_type(8)));
typedef __bf16 bf16x2_t __attribute__((ext_vector_type(2)));
typedef float f32x2_t __attribute__((ext_vector_type(2)));
__device__ __forceinline__ unsigned pkbf(float lo, float hi) { const f32x2_t v = {lo, hi}; return __builtin_bit_cast(unsigned, __builtin_convertvector(v, bf16x2_t)); }
#define MFMA32(a, b, c) __builtin_amdgcn_mfma_f32_32x32x16_bf16((a), (b), (c), 0, 0, 0)
__device__ __forceinline__ int swz16(int row) { return ((row & 3) << 2) | ((row >> 2) & 3); }
__device__ __forceinline__ s16x8 tr_pair(LAS unsigned char* p0, LAS unsigned char* p1) {
    const s16x4 lo = __builtin_amdgcn_ds_read_tr16_b64_v4i16((LAS s16x4*)p0), hi = __builtin_amdgcn_ds_read_tr16_b64_v4i16((LAS s16x4*)p1);
    return __builtin_shufflevector(lo, hi, 0, 1, 2, 3, 4, 5, 6, 7);
}
__device__ __forceinline__ void glds16_asm(const GAS void* gsrc, unsigned lds_dst) {
    unsigned keep;
    asm volatile("s_mov_b32 %0, m0\n\ts_mov_b32 m0, %2\n\ts_nop 0\n\tglobal_load_lds_dwordx4 %1, off\n\ts_mov_b32 m0, %0" : "=&s"(keep) : "v"(gsrc), "s"(lds_dst) : "memory");
}
constexpr int RF_KT = 0, RF_VT = 65536, RF_RT = 81920, RF_OX = 114688;
static_assert(RF_OX + 32768 <= RING_BYTES, "retention LDS map");

#ifndef PROBE_BLK
#define PROBE_BLK 0
#define PROBE_WAVE 0
#endif
__device__ __forceinline__ void ret_fast(Frame& F, const gbf16* Qh, const gbf16* Kt, const gbf16* V, const gf32* gC, const gbf16* Gt, gbf16* OBg, gf32* SSQo, gf32* SoutP, GAS void* probe_out) {
    LAS unsigned char* L = F.lds + RING_OFF;
    const unsigned Lb = (unsigned)(size_t)L;
    const int wave = F.wave;
    const int kh = wave >> 2, tt = ((wave >> 1) ^ (wave >> 2)) & 1, et = wave & 1;
    const int nown = tt == 0 ? 3 : 1, dtb = tt == 0 ? 3 * kh : 6 + kh;
    constexpr int NCH = TP / R_C;
    for (int u = blockIdx.x; u < NSEQ_P * R_H * 8; u += F.G) {
        const int pair = (u & 7) * 4 + ((u >> 3) >> 3), sl = (u >> 3) & 7;
        const int b = pair >> 2, h = pair & 3;
        const int rowb = b * TP;
        const float gsc = gC[h * 2];
        int lane0 = F.lane; asm volatile("" : "+v"(lane0));
        f32x16 racc[3];
#pragma unroll
        for (int i = 0; i < 3; ++i)
#pragma unroll
            for (int r = 0; r < 16; ++r) racc[i][r] = 0.f;
        for (int i = F.tid; i < 32768 / 16; i += NWAVES * 64) *(LAS v4u*)(L + RF_RT + i * 16) = (v4u){0u, 0u, 0u, 0u};
#define RF_DMA(c_) do { const int cr0_ = rowb + (c_) * R_C; const unsigned kb_ = Lb + RF_KT + ((c_) & 1) * 32768 + 8 * wave * 512, vb_ = Lb + RF_VT + ((c_) & 1) * 8192 + 8 * wave * 128; \
            _Pragma("unroll") for (int i_ = 0; i_ < 4; ++i_) { const int row_ = 8 * wave + 2 * i_ + (lane >> 5), ch_ = (lane & 31) ^ swz16(row_); \
                glds16_asm((const GAS void*)(Kt + (size_t)(cr0_ + row_) * R_QK + h * R_DK + 8 * ch_), __builtin_amdgcn_readfirstlane(kb_ + i_ * 1024)); } \
            { const int row_ = 8 * wave + (lane >> 3), ch_ = (lane & 7) ^ (((row_ >> 1) & 1) << 2); \
              glds16_asm((const GAS void*)(V + (size_t)(cr0_ + row_) * R_V + h * R_DV + sl * 64 + 8 * ch_), __builtin_amdgcn_readfirstlane(vb_)); } } while (0)
#if defined(PROBE_SEC) && PROBE_SEC >= 10
        unsigned long long rprobe_acc = 0;
#endif
        s16x8 qf[8];
#define RF_LOADQ(c_) do { const gbf16* qptr_ = Qh + (size_t)(rowb + (c_) * R_C + 32 * tt + (lane & 31)) * R_QK + h * R_DK + 128 * kh + 8 * (lane >> 5); \
            _Pragma("unroll") for (int ks_ = 0; ks_ < 8; ++ks_) qf[ks_] = *(const GAS s16x8*)(qptr_ + 16 * ks_); } while (0)
        { const int lane = lane0; RF_DMA(0); RF_LOADQ(0); }
        __builtin_amdgcn_s_waitcnt(0x0070);
        for (int c = 0; c < NCH; ++c) {
            const int crow0 = rowb + c * R_C;
            int lane = F.lane; asm volatile("" : "+v"(lane));
            const int l31 = lane & 31, hh = lane >> 5, i16 = lane & 15, q4 = i16 >> 2, p4 = i16 & 3, gb = (lane >> 4) & 1;
            const int erow = 32 * et + l31, esw = swz16(erow), ksw = swz16(l31);
            LAS unsigned char* KTb = L + RF_KT + (c & 1) * 32768;
            LAS unsigned char* VTb = L + RF_VT + (c & 1) * 8192;
#if defined(PROBE_SEC) && PROBE_SEC >= 10
            const unsigned long long rp0 = __builtin_amdgcn_s_memtime();
#endif
            __builtin_amdgcn_s_waitcnt(0x0072);
            __builtin_amdgcn_s_barrier(); asm volatile("" ::: "memory");
#if defined(PROBE_SEC) && PROBE_SEC >= 10
            const unsigned long long rp1 = __builtin_amdgcn_s_memtime();
#endif
            if (c + 1 < NCH) RF_DMA(c + 1);
#if defined(PROBE_SEC) && PROBE_SEC >= 10
            const unsigned long long rp2 = __builtin_amdgcn_s_memtime();
#endif
            f32x16 oacc;
#pragma unroll
            for (int r = 0; r < 16; ++r) oacc[r] = 0.f;
#pragma unroll
            for (int ks = 0; ks < 8; ++ks) {
                const s16x8 rf = *(const LAS s16x8*)(L + RF_RT + erow * 512 + 16 * ((2 * (8 * kh + ks) + hh) ^ esw));
                oacc = MFMA32(qf[ks], rf, oacc);
            }
#if defined(PROBE_SEC) && PROBE_SEC >= 10
            asm volatile("s_nop 0" :: "v"(oacc[0]), "v"(oacc[15]));
            const unsigned long long rp3 = __builtin_amdgcn_s_memtime();
#endif
            LAS unsigned char* vbase = VTb + (4 * hh + q4) * 128 + 16 * ((4 * et + 2 * gb + (p4 >> 1)) ^ (((q4 >> 1) & 1) << 2)) + 8 * (p4 & 1);
#pragma unroll 1
            for (int st = 0; st <= tt; ++st) {
                f32x16 X;
#pragma unroll
                for (int r = 0; r < 16; ++r) X[r] = 0.f;
                LAS unsigned char* kb_ = KTb + (32 * st + l31) * 512;
#pragma unroll
                for (int ks = 0; ks < 8; ++ks) { const s16x8 kf = *(const LAS s16x8*)(kb_ + 16 * ((2 * (8 * kh + ks) + hh) ^ ksw)); X = MFMA32(kf, qf[ks], X); }
                if (st == tt) {
#pragma unroll
                    for (int r = 0; r < 16; ++r) { const int sl_ = (r & 3) + 8 * (r >> 2) + 4 * hh; X[r] = sl_ <= l31 ? X[r] : 0.f; }
                }
#pragma unroll
                for (int s2 = 0; s2 < 2; ++s2) {
                    LAS unsigned char* vp = vbase + (2 * st + s2) * 2048;
                    const s16x8 vf = tr_pair(vp, vp + 1024);
                    v4u pk; pk.x = pkbf(X[8 * s2 + 0], X[8 * s2 + 1]); pk.y = pkbf(X[8 * s2 + 2], X[8 * s2 + 3]); pk.z = pkbf(X[8 * s2 + 4], X[8 * s2 + 5]); pk.w = pkbf(X[8 * s2 + 6], X[8 * s2 + 7]);
                    oacc = MFMA32(__builtin_bit_cast(s16x8, pk), vf, oacc);
                }
            }
#if defined(PROBE_SEC) && PROBE_SEC >= 10
            asm volatile("s_nop 0" :: "v"(oacc[0]), "v"(oacc[15]));
            const unsigned long long rp4 = __builtin_amdgcn_s_memtime();
#endif
            if (c + 1 < NCH) RF_LOADQ(c + 1);
#if defined(PROBE_SEC) && PROBE_SEC >= 10
            const unsigned long long rp5 = __builtin_amdgcn_s_memtime();
#endif
            {
                LAS unsigned char* kt0 = KTb + (4 * hh + q4) * 512 + 8 * (p4 & 1);
                const int sw0 = (q4 << 2) | hh, sw1 = (q4 << 2) | ((hh + 2) & 3);
                const int cl = 2 * gb + (p4 >> 1);
                int o0[3], o1[3];
#pragma unroll
                for (int i = 0; i < 3; ++i) { o0[i] = 16 * ((4 * (dtb + i) + cl) ^ sw0); o1[i] = 16 * ((4 * (dtb + i) + cl) ^ sw1) + 8 * 512; }
#pragma unroll
                for (int k8 = 0; k8 < R_C / 16; ++k8) {
                    LAS unsigned char* vp = vbase + k8 * 2048;
                    const s16x8 vf = tr_pair(vp, vp + 1024);
                    { const s16x8 ka = tr_pair(kt0 + k8 * 8192 + o0[0], kt0 + k8 * 8192 + o1[0]); racc[0] = MFMA32(ka, vf, racc[0]); }
                    if (nown == 3) {
                        const s16x8 kb2 = tr_pair(kt0 + k8 * 8192 + o0[1], kt0 + k8 * 8192 + o1[1]); racc[1] = MFMA32(kb2, vf, racc[1]);
                        const s16x8 kc2 = tr_pair(kt0 + k8 * 8192 + o0[2], kt0 + k8 * 8192 + o1[2]); racc[2] = MFMA32(kc2, vf, racc[2]);
                    }
                }
            }
#pragma unroll
            for (int i = 0; i < 3; ++i)
#pragma unroll
                for (int r = 0; r < 16; ++r) racc[i][r] *= gsc;
#if defined(PROBE_SEC) && PROBE_SEC >= 10
            const unsigned long long rp6 = __builtin_amdgcn_s_memtime();
#endif
            {
                LAS float* ox = (LAS float*)(L + RF_OX + ((tt * 2 + et) * 2 + kh) * 4096) + (4 * hh) * 32 + l31;
#pragma unroll
                for (int r = 0; r < 16; ++r) ox[((r & 3) + 8 * (r >> 2)) * 32] = oacc[r];
            }
            asm volatile("s_waitcnt lgkmcnt(0)" ::: "memory"); __builtin_amdgcn_s_barrier(); asm volatile("" ::: "memory");
            {
                const int t = F.tid >> 3, cg = F.tid & 7;
                const LAS unsigned char* p0 = L + RF_OX + (((t >> 5) * 2 + (cg >> 2)) * 2) * 4096 + (t & 31) * 128 + (cg & 3) * 32;
                const pg8::f32x4 a0 = *(const LAS pg8::f32x4*)p0, a1 = *(const LAS pg8::f32x4*)(p0 + 16), b0 = *(const LAS pg8::f32x4*)(p0 + 4096), b1 = *(const LAS pg8::f32x4*)(p0 + 4096 + 16);
                const size_t oi = (size_t)(crow0 + t) * R_V + h * R_DV + sl * 64 + 8 * cg;
                const v4u g = *(const gv4u*)(Gt + oi);
                const pg8::f32x4 o0 = a0 + b0, o1 = a1 + b1;
                v4u w; w.x = pkbf(o0[0] * bflo(g.x), o0[1] * bfhi(g.x)); w.y = pkbf(o0[2] * bflo(g.y), o0[3] * bfhi(g.y)); w.z = pkbf(o1[0] * bflo(g.z), o1[1] * bfhi(g.z)); w.w = pkbf(o1[2] * bflo(g.w), o1[3] * bfhi(g.w));
                *(gv4u*)(OBg + oi) = w;
                float ss = ((o0[0] * o0[0] + o0[1] * o0[1]) + (o0[2] * o0[2] + o0[3] * o0[3])) + ((o1[0] * o1[0] + o1[1] * o1[1]) + (o1[2] * o1[2] + o1[3] * o1[3]));
                ss += __shfl_xor(ss, 1); ss += __shfl_xor(ss, 2); ss += __shfl_xor(ss, 4);
                if (cg == 0) SSQo[(size_t)(crow0 + t) * 32 + h * 8 + sl] = ss;
            }
            if (c + 1 < NCH) {
#pragma unroll
                for (int i = 0; i < 3; ++i)
                    if (i < nown) {
#pragma unroll
                        for (int g = 0; g < 4; ++g) {
                            v2u w; w.x = pkbf(racc[i][4 * g], racc[i][4 * g + 1]); w.y = pkbf(racc[i][4 * g + 2], racc[i][4 * g + 3]);
                            *(LAS v2u*)(L + RF_RT + erow * 512 + 16 * ((4 * (dtb + i) + g) ^ esw) + 8 * hh) = w;
                        }
                    }
            }
#if defined(PROBE_SEC) && PROBE_SEC >= 10
            { asm volatile("s_nop 0" :: "v"(racc[0][0]), "v"(racc[0][15]));
              const unsigned long long rp7 = __builtin_amdgcn_s_memtime();
              const unsigned long long d_ = PROBE_SEC == 10 ? rp1 - rp0 : PROBE_SEC == 11 ? rp2 - rp1 : PROBE_SEC == 12 ? rp3 - rp2 : PROBE_SEC == 13 ? rp4 - rp3 : PROBE_SEC == 14 ? rp5 - rp4 : PROBE_SEC == 15 ? rp6 - rp5 : PROBE_SEC == 16 ? rp7 - rp6 : rp7 - rp0;
              if (c >= 2) rprobe_acc += d_; }
#endif
        }
#if defined(PROBE_SEC) && PROBE_SEC >= 10
        if (blockIdx.x == PROBE_BLK && F.tid == PROBE_WAVE * 64) *(GAS unsigned long long*)probe_out = rprobe_acc / (NCH - 2);
#endif
#undef RF_DMA
#undef RF_LOADQ
        {
            const int l31 = lane0 & 31, hh = lane0 >> 5;
            gf32* sp = SoutP + ((size_t)(b * R_H + h) * R_DK + 4 * hh) * R_DV + sl * 64 + 32 * et + l31;
#pragma unroll
            for (int i = 0; i < 3; ++i)
                if (i < nown) {
#pragma unroll
                    for (int r = 0; r < 16; ++r) sp[(size_t)(32 * (dtb + i) + (r & 3) + 8 * (r >> 2)) * R_DV] = racc[i][r];
                }
        }
        asm volatile("s_waitcnt vmcnt(0) lgkmcnt(0)" ::: "memory"); __builtin_amdgcn_s_barrier(); asm volatile("" ::: "memory");
    }
}

#define MFMA16(a, b, c) __builtin_amdgcn_mfma_f32_16x16x32_bf16((a), (b), (c), 0, 0, 0)
constexpr int HF_KT = 0, HF_QT = 4096 + 64, HF_VT = 8192 + 128, HF_EB = 12288 + 192, HF_SLOT = 13568, HF_NSLOT = 4;
static_assert(HF_SLOT * HF_NSLOT <= RING_BYTES, "hgrn ring");
__device__ __forceinline__ void hg_fast(Frame& F, const gbf16* Qb, const gbf16* Kt, const gbf16* V, const gf32* EB, gbf16* O  , gf32* SoutP, GAS void* probe_out) {
    const int wave = F.wave;
    const unsigned Lb = (unsigned)(size_t)(F.lds + RING_OFF);
    LAS unsigned char* L = F.lds + RING_OFF;
    for (int u = blockIdx.x; u < NSEQ_P * G_H; u += F.G) {
        const int b = u >> 3, h = u & 7;
        int lane = F.lane; asm volatile("" : "+v"(lane));
        const int c16 = lane & 15, quad = lane >> 4;
        const size_t rowb = (size_t)b * TP;
        const int wl = wave & 3, prow = 4 * wl + quad, plc = 2 * ((c16 >> 1) ^ (prow & 7)) + ((c16 & 1) ^ (prow >> 3));
        const gbf16* srcA = (wave < 4 ? Kt : Qb) + (rowb + prow) * D + h * G_DK + 8 * plc;
        const gbf16* srcBv = V + (rowb + prow) * D + h * G_DV + 8 * plc;
        const gf32* srcBe = EB + (rowb >> 4) * D + h * G_DK + 4 * (lane & 31);
        const unsigned dstA = __builtin_amdgcn_readfirstlane(Lb + (wave < 4 ? HF_KT : HF_QT) + wl * 1024), dstB = __builtin_amdgcn_readfirstlane(Lb + (wave < 4 ? HF_VT + wl * 1024 : HF_EB));
#define HF_DMA(ci_) do { const int cc_ = (ci_) < TP / 16 ? (ci_) : TP / 16 - 1; const unsigned so_ = (unsigned)(((ci_) & (HF_NSLOT - 1)) * HF_SLOT); \
            glds16_asm((const GAS void*)(srcA + (size_t)cc_ * 16 * D), dstA + so_); \
            if (wave < 4) glds16_asm((const GAS void*)(srcBv + (size_t)cc_ * 16 * D), dstB + so_); else glds16_asm((const GAS void*)(srcBe + (size_t)cc_ * D), dstB + so_); } while (0)
        pg8::f32x4 R[8];
#pragma unroll
        for (int t = 0; t < 8; ++t) R[t] = (pg8::f32x4){0.f, 0.f, 0.f, 0.f};
#if defined(PROBE_SEC) && PROBE_SEC < 10
        unsigned long long probe_acc = 0;
#endif
        HF_DMA(0); HF_DMA(1);
        __builtin_amdgcn_s_waitcnt(0x0F70);
#pragma unroll 1
        for (int ci = 0; ci < TP / 16; ++ci) {
#if defined(PROBE_SEC) && PROBE_SEC < 10
            const unsigned long long tp0 = __builtin_amdgcn_s_memtime();
#endif
            if (ci < 2) asm volatile("s_waitcnt vmcnt(0)" ::: "memory"); else asm volatile("s_waitcnt vmcnt(10)" ::: "memory");
#if defined(PROBE_SEC) && PROBE_SEC < 10
            const unsigned long long tp1 = __builtin_amdgcn_s_memtime();
#endif
            __builtin_amdgcn_s_barrier(); asm volatile("" ::: "memory");
#if defined(PROBE_SEC) && PROBE_SEC < 10
            const unsigned long long tp2 = __builtin_amdgcn_s_memtime();
#endif
            HF_DMA(ci + 2);
            LAS unsigned char* sb = L + (ci & (HF_NSLOT - 1)) * HF_SLOT;
            v4u kf[4], qf[4]; v2u ktr[8];
#pragma unroll
            for (int kk = 0; kk < 4; ++kk) {
                const int qo = 16 * ((quad >> 1) ^ (c16 >> 3)) + 8 * (quad & 1);
                const int o0 = c16 * 256 + 32 * ((2 * kk) ^ (c16 & 7)) + qo, o1 = c16 * 256 + 32 * ((2 * kk + 1) ^ (c16 & 7)) + qo;
                const v2u ka = *(const LAS v2u*)(sb + HF_KT + o0), kb = *(const LAS v2u*)(sb + HF_KT + o1), qa = *(const LAS v2u*)(sb + HF_QT + o0), qb = *(const LAS v2u*)(sb + HF_QT + o1);
                kf[kk] = (v4u){ka.x, ka.y, kb.x, kb.y}; qf[kk] = (v4u){qa.x, qa.y, qb.x, qb.y};
            }
            const int tok = 4 * quad + (c16 >> 2);
            const int po = 16 * (((c16 & 3) >> 1) ^ (tok >> 3)) + 8 * (c16 & 1);
            const v2u vtr = __builtin_bit_cast(v2u, __builtin_amdgcn_ds_read_tr16_b64_v4i16((LAS s16x4*)(sb + HF_VT + tok * 256 + 32 * (wave ^ (tok & 7)) + po)));
#pragma unroll
            for (int t = 0; t < 8; ++t) ktr[t] = __builtin_bit_cast(v2u, __builtin_amdgcn_ds_read_tr16_b64_v4i16((LAS s16x4*)(sb + HF_KT + tok * 256 + 32 * (t ^ (tok & 7)) + po)));
#if defined(PROBE_SEC) && PROBE_SEC < 10
            asm volatile("s_waitcnt lgkmcnt(0)" ::: "memory");
            const unsigned long long tp3 = __builtin_amdgcn_s_memtime();
#endif
            __builtin_amdgcn_sched_barrier(0);
            const v4u vB4 = (v4u){vtr.x, vtr.y, 0u, 0u};
            pg8::f32x4 PT = (pg8::f32x4){0.f, 0.f, 0.f, 0.f};
#pragma unroll
            for (int kk = 0; kk < 4; ++kk) PT = MFMA16(__builtin_bit_cast(pg8::bf16x8, kf[kk]), __builtin_bit_cast(pg8::bf16x8, qf[kk]), PT);
            pg8::f32x4 oacc = (pg8::f32x4){0.f, 0.f, 0.f, 0.f};
#pragma unroll
            for (int kk = 0; kk < 4; ++kk) {
                const v4u rB = (v4u){pkbf(R[2 * kk][0], R[2 * kk][1]), pkbf(R[2 * kk][2], R[2 * kk][3]), pkbf(R[2 * kk + 1][0], R[2 * kk + 1][1]), pkbf(R[2 * kk + 1][2], R[2 * kk + 1][3])};
                oacc = MFMA16(__builtin_bit_cast(pg8::bf16x8, qf[kk]), __builtin_bit_cast(pg8::bf16x8, rB), oacc);
            }
#pragma unroll
            for (int t = 0; t < 8; ++t) { const v4u kA = (v4u){ktr[t].x, ktr[t].y, 0u, 0u}; R[t] = MFMA16(__builtin_bit_cast(pg8::bf16x8, kA), __builtin_bit_cast(pg8::bf16x8, vB4), R[t]); }
#pragma unroll
            for (int r = 0; r < 4; ++r) PT[r] = (4 * quad + r) <= c16 ? PT[r] : 0.f;
            const v4u pA = (v4u){pkbf(PT[0], PT[1]), pkbf(PT[2], PT[3]), 0u, 0u};
            oacc = MFMA16(__builtin_bit_cast(pg8::bf16x8, pA), __builtin_bit_cast(pg8::bf16x8, vB4), oacc);
#pragma unroll
            for (int t = 0; t < 8; ++t) { const pg8::f32x4 e4 = *(const LAS pg8::f32x4*)(sb + HF_EB + (16 * t + 4 * quad) * 4); R[t] = R[t] * e4; }
            {
                gbf16* op = O + (rowb + (size_t)ci * 16 + 4 * quad) * D + h * G_DV + 16 * wave + c16;
#pragma unroll
                for (int r = 0; r < 4; ++r) op[(size_t)r * D] = (bf16)(pkbf(oacc[r], 0.f) & 0xffffu);
            }
#if defined(PROBE_SEC) && PROBE_SEC < 10
            { asm volatile("s_nop 0" :: "v"(R[0][0]), "v"(R[7][3]));
              const unsigned long long tp4 = __builtin_amdgcn_s_memtime();
              const unsigned long long d_ = PROBE_SEC == 0 ? tp1 - tp0 : PROBE_SEC == 1 ? tp2 - tp1 : PROBE_SEC == 2 ? tp3 - tp2 : PROBE_SEC == 3 ? tp4 - tp3 : tp4 - tp0;
              if (ci >= 8) probe_acc += d_; }
#endif
        }
#if defined(PROBE_SEC) && PROBE_SEC < 10
        if (blockIdx.x == 0 && F.tid == 0) *(GAS unsigned long long*)probe_out = probe_acc / (TP / 16 - 8);
#endif
#undef HF_DMA
        {
            gf32* sp = SoutP + ((size_t)(b * G_H + h) * G_DK + 4 * quad) * G_DV + 16 * wave + c16;
#pragma unroll
            for (int t = 0; t < 8; ++t)
#pragma unroll
                for (int r = 0; r < 4; ++r) sp[(size_t)(16 * t + r) * G_DV] = R[t][r];
        }
        asm volatile("s_waitcnt vmcnt(0) lgkmcnt(0)" ::: "memory"); __builtin_amdgcn_s_barrier(); asm volatile("" ::: "memory");
    }
}

__device__ __forceinline__ void mini_res_gemm(Frame& F, const gbf16* A, const gbf16* Wt, int K, gbf16* xb, gf32* ssq_out, float scale, const gf32* rt8 = nullptr  ) {
    LAS unsigned char* L = F.lds + RING_OFF;
    const int lane = F.lane, wave = F.wave, r16 = lane & 15, quad = lane >> 4;
    const int kw = K >> 3, nks = kw >> 5;
    for (int tile = blockIdx.x; tile < 256; tile += F.G) {
        const int rt = tile >> 4, ct = tile & 15;
        const gbf16* ap = A + (size_t)(MP + 32 * rt + (lane >> 2)) * K + wave * kw + 8 * (lane & 3);
        const gbf16* bp = Wt + (size_t)(64 * ct + (lane >> 2)) * K + wave * kw + 8 * (lane & 3);
        const int psrc = (4 * r16 + quad) * 4;
        const int erow = F.tid >> 4, ec4 = F.tid & 15;
        const v2u hpre = *(const GAS v2u*)(xb + (size_t)(MP + 32 * rt + erow) * D + 64 * ct + 4 * ec4);
        pg8::f32x4 acc[2][4];
#pragma unroll
        for (int i = 0; i < 2; ++i)
#pragma unroll
            for (int j = 0; j < 4; ++j) acc[i][j] = (pg8::f32x4){0.f, 0.f, 0.f, 0.f};
        v4u fa[2][2], fb[2][4];
#pragma unroll
        for (int i = 0; i < 2; ++i) fa[0][i] = *(const GAS v4u*)(ap + (size_t)(16 * i) * K);
#pragma unroll
        for (int j = 0; j < 4; ++j) fb[0][j] = *(const GAS v4u*)(bp + (size_t)(16 * j) * K);
        for (int ks = 0; ks < nks; ks += 2) {
#pragma unroll
            for (int half = 0; half < 2; ++half) {
                const int kn = ks + half + 1;
                const int ko = 32 * (kn < nks ? kn : nks - 1);
#pragma unroll
                for (int i = 0; i < 2; ++i) fa[half ^ 1][i] = *(const GAS v4u*)(ap + (size_t)(16 * i) * K + ko);
#pragma unroll
                for (int j = 0; j < 4; ++j) fb[half ^ 1][j] = *(const GAS v4u*)(bp + (size_t)(16 * j) * K + ko);
                __builtin_amdgcn_sched_barrier(0);
                if (ks + half < nks) {
#pragma unroll
                    for (int i = 0; i < 2; ++i) { v4u& x = fa[half][i]; x.x = __builtin_amdgcn_ds_bpermute(psrc, x.x); x.y = __builtin_amdgcn_ds_bpermute(psrc, x.y); x.z = __builtin_amdgcn_ds_bpermute(psrc, x.z); x.w = __builtin_amdgcn_ds_bpermute(psrc, x.w); }
#pragma unroll
                    for (int j = 0; j < 4; ++j) { v4u& x = fb[half][j]; x.x = __builtin_amdgcn_ds_bpermute(psrc, x.x); x.y = __builtin_amdgcn_ds_bpermute(psrc, x.y); x.z = __builtin_amdgcn_ds_bpermute(psrc, x.z); x.w = __builtin_amdgcn_ds_bpermute(psrc, x.w); }
#pragma unroll
                    for (int i = 0; i < 2; ++i)
#pragma unroll
                        for (int j = 0; j < 4; ++j) acc[i][j] = MFMA16(__builtin_bit_cast(pg8::bf16x8, fb[half][j]), __builtin_bit_cast(pg8::bf16x8, fa[half][i]), acc[i][j]);
                }
                __builtin_amdgcn_sched_barrier(0);
            }
        }
        if (rt8) {
#pragma unroll
            for (int i = 0; i < 2; ++i) { const float r = ret_head_rstd(rt8, MP + 32 * rt + 16 * i + r16, wave >> 1);
#pragma unroll
                for (int j = 0; j < 4; ++j) acc[i][j] = acc[i][j] * r; }
        }
#pragma unroll
        for (int i = 0; i < 2; ++i)
#pragma unroll
            for (int j = 0; j < 4; ++j) *(LAS pg8::f32x4*)(L + wave * 8192 + (16 * i + r16) * 256 + (16 * j + 4 * quad) * 4) = acc[i][j];
        LDS_WAIT(); __syncthreads();
        {
            const int row = erow, c4 = ec4;
            pg8::f32x4 s = *(const LAS pg8::f32x4*)(L + row * 256 + c4 * 16);
#pragma unroll
            for (int w = 1; w < 8; ++w) s = s + *(const LAS pg8::f32x4*)(L + w * 8192 + row * 256 + c4 * 16);
            const size_t off = (size_t)(MP + 32 * rt + row) * D + 64 * ct + 4 * c4;
            const v2u hh = hpre;
            const pg8::f32x4 x = (pg8::f32x4){bflo(hh.x), bfhi(hh.x), bflo(hh.y), bfhi(hh.y)} + s * scale;
            v2u wb; wb.x = pkbf(x[0], x[1]); wb.y = pkbf(x[2], x[3]);
            *(GAS v2u*)(xb + off) = wb;

            float ss = (x[0] * x[0] + x[1] * x[1]) + (x[2] * x[2] + x[3] * x[3]);
            ss += __shfl_xor(ss, 1); ss += __shfl_xor(ss, 2); ss += __shfl_xor(ss, 4); ss += __shfl_xor(ss, 8);
            if (c4 == 0) ssq_out[(size_t)(MP + 32 * rt + row) * SSQ_SLOTS + ct] = ss;
        }
        LDS_WAIT(); __syncthreads();
    }
}

constexpr int R3_KT = 0, R3_VT = 65536, R3_RT = 81920, R3_QT = 114688, R3_QK = 147456, R3_END = 155648;
static_assert(R3_END <= RING_BYTES, "retention LDS map");

__device__ __forceinline__ void ret_rec3(Frame& F, const gbf16* Qh, const gbf16* Kt, const gbf16* V, const gf32* gC, const gbf16* Gt, gbf16* OBg, gf32* SSQo,
                                         const gf32* S0, gf32* SoutP, gf32* SoutS, GAS void* probe_out) {
    LAS unsigned char* L = F.lds + RING_OFF;
    const unsigned Lb = (unsigned)(size_t)L;
    const int wave = F.wave;
    constexpr int NCH = TP / R_C;
    for (int u = blockIdx.x; u < NSEQ_P * R_H * 8; u += F.G) {
        { int t_ = F.tid; unsigned z_ = 0; asm volatile("" : "+v"(t_), "+v"(z_));
          for (int i = t_; i < 32768 / 16; i += NWAVES * 64) *(LAS v4u*)(L + R3_RT + i * 16) = (v4u){z_, z_, z_, z_}; }
        if (wave < 4) {
            const int tt = (wave >> 1) & 1, et = wave & 1, dtb = 4 * tt;
            const int pair = (u & 7) * 4 + ((u >> 3) >> 3), sl = (u >> 3) & 7;
            const int b = pair >> 2, h = pair & 3;
            const int rowb = b * TP;
            const float gsc = gC[h * 2];
            int lane0 = F.lane; asm volatile("" : "+v"(lane0));
            f32x16 racc[4];
#pragma unroll
            for (int i = 0; i < 4; ++i)
#pragma unroll
                for (int r = 0; r < 16; ++r) racc[i][r] = 0.f;
#if defined(PROBE_SEC) && PROBE_SEC >= 20
            unsigned long long qprobe = 0, qbest = ~0ull;
#endif
#pragma unroll 1
            for (int c = 0; c < NCH; ++c) {
                const int crow0 = rowb + c * R_C;
                int lane = F.lane; asm volatile("" : "+v"(lane));
                const int l31 = lane & 31, hh = lane >> 5, i16 = lane & 15, q4 = i16 >> 2, p4 = i16 & 3, gb = (lane >> 4) & 1;
                const int erow = 32 * et + l31, esw = swz16(erow), ksw = swz16(l31);
                LAS unsigned char* KTb = L + R3_KT + (c & 1) * 32768;
                LAS unsigned char* VTb = L + R3_VT + (c & 1) * 8192;
#if defined(PROBE_SEC) && PROBE_SEC >= 20
                const unsigned long long qq0 = __builtin_amdgcn_s_memtime();
#endif
                asm volatile("s_waitcnt lgkmcnt(0)" ::: "memory");
                __builtin_amdgcn_s_barrier(); asm volatile("" ::: "memory");
#if defined(PROBE_SEC) && PROBE_SEC >= 20
                const unsigned long long qq1 = __builtin_amdgcn_s_memtime();
#endif
                v2u gfr[4];
#pragma unroll
                for (int i = 0; i < 4; ++i) gfr[i] = *(const GAS v2u*)(Gt + (size_t)(crow0 + 32 * tt + 8 * i + (lane >> 3)) * R_V + h * R_DV + sl * 64 + 32 * et + 4 * (lane & 7));
                s16x8 qf[16];
                {
                    LAS unsigned char* qrow = L + R3_QT + (32 * tt + l31) * 512;
#pragma unroll
                    for (int ks = 0; ks < 16; ++ks) qf[ks] = *(const LAS s16x8*)(qrow + 16 * ((2 * ks + hh) ^ ksw));
                }
                asm volatile("s_waitcnt lgkmcnt(0)" ::: "memory"); __builtin_amdgcn_s_barrier(); asm volatile("" ::: "memory");
                f32x16 oacc;
#pragma unroll
                for (int r = 0; r < 16; ++r) oacc[r] = 0.f;
#pragma unroll
                for (int ks = 0; ks < 16; ++ks) {
                    const s16x8 rf = *(const LAS s16x8*)(L + R3_RT + erow * 512 + 16 * ((2 * ks + hh) ^ esw));
                    oacc = MFMA32(qf[ks], rf, oacc);
                }
#if defined(PROBE_SEC) && PROBE_SEC >= 20
                asm volatile("s_nop 0" :: "v"(oacc[0]), "v"(oacc[15]));
#endif
#if defined(PROBE_SEC) && PROBE_SEC >= 20
                const unsigned long long qq2 = __builtin_amdgcn_s_memtime();
#endif
                LAS unsigned char* vbase = VTb + (4 * hh + q4) * 128 + 16 * ((4 * et + 2 * gb + (p4 >> 1)) ^ (((q4 >> 1) & 1) << 2)) + 8 * (p4 & 1);
#pragma unroll 1
                for (int st = 0; st <= tt; ++st) {
                    f32x16 X;
#pragma unroll
                    for (int r = 0; r < 16; ++r) X[r] = 0.f;
                    LAS unsigned char* kb_ = KTb + (32 * st + l31) * 512;
#pragma unroll
                    for (int ks = 0; ks < 16; ++ks) { const s16x8 kf = *(const LAS s16x8*)(kb_ + 16 * ((2 * ks + hh) ^ ksw)); X = MFMA32(kf, qf[ks], X); }
                    if (st == tt) {
#pragma unroll
                        for (int r = 0; r < 16; ++r) { const int sl_ = (r & 3) + 8 * (r >> 2) + 4 * hh; X[r] = sl_ <= l31 ? X[r] : 0.f; }
                    }
#pragma unroll
                    for (int s2 = 0; s2 < 2; ++s2) {
                        LAS unsigned char* vp = vbase + (2 * st + s2) * 2048;
                        const s16x8 vf = tr_pair(vp, vp + 1024);
                        v4u pk; pk.x = pkbf(X[8 * s2 + 0], X[8 * s2 + 1]); pk.y = pkbf(X[8 * s2 + 2], X[8 * s2 + 3]); pk.z = pkbf(X[8 * s2 + 4], X[8 * s2 + 5]); pk.w = pkbf(X[8 * s2 + 6], X[8 * s2 + 7]);
                        oacc = MFMA32(__builtin_bit_cast(s16x8, pk), vf, oacc);
                    }
                }
#if defined(PROBE_SEC) && PROBE_SEC >= 20
                asm volatile("s_nop 0" :: "v"(oacc[0]), "v"(oacc[15]));
#endif
#if defined(PROBE_SEC) && PROBE_SEC >= 20
                const unsigned long long qq3 = __builtin_amdgcn_s_memtime();
#endif
#if defined(PROBE_SEC) && PROBE_SEC >= 20
                const unsigned long long qq4 = __builtin_amdgcn_s_memtime();
#endif
                {
                    LAS unsigned char* kt0 = KTb + (4 * hh + q4) * 512 + 8 * (p4 & 1);
                    const int sw0 = (q4 << 2) | hh, sw1 = (q4 << 2) | ((hh + 2) & 3);
                    const int cl = 2 * gb + (p4 >> 1);
#pragma unroll
                    for (int k8 = 0; k8 < R_C / 16; ++k8) {
                        LAS unsigned char* vp = vbase + k8 * 2048;
                        const s16x8 vf = tr_pair(vp, vp + 1024);
#pragma unroll
                        for (int i = 0; i < 4; ++i) {
                            const int o0 = 16 * ((4 * (dtb + i) + cl) ^ sw0), o1 = 16 * ((4 * (dtb + i) + cl) ^ sw1) + 8 * 512;
                            const s16x8 ka = tr_pair(kt0 + k8 * 8192 + o0, kt0 + k8 * 8192 + o1); racc[i] = MFMA32(ka, vf, racc[i]);
                        }
                    }
                }
#pragma unroll
                for (int i = 0; i < 4; ++i)
#pragma unroll
                    for (int r = 0; r < 16; ++r) racc[i][r] *= gsc;
#if defined(PROBE_SEC) && PROBE_SEC >= 20
                asm volatile("s_nop 0" :: "v"(racc[0][0]), "v"(racc[3][15]));
#endif
#if defined(PROBE_SEC) && PROBE_SEC >= 20
                const unsigned long long qq5 = __builtin_amdgcn_s_memtime();
#endif
                asm volatile("s_waitcnt lgkmcnt(0)" ::: "memory"); __builtin_amdgcn_s_barrier(); asm volatile("" ::: "memory");
#if defined(PROBE_SEC) && PROBE_SEC >= 20
                const unsigned long long qq6 = __builtin_amdgcn_s_memtime();
#endif
                LAS unsigned char* OTb = KTb + wave * 4096;
                {
                    LAS float* ox = (LAS float*)OTb + (4 * hh) * 32 + l31;
#pragma unroll
                    for (int r = 0; r < 16; ++r) ox[((r & 3) + 8 * (r >> 2)) * 32] = oacc[r];
                }
#pragma unroll
                for (int i = 0; i < 4; ++i) {
                    const int trow = 8 * i + (lane >> 3);
                    const pg8::f32x4 o = *(const LAS pg8::f32x4*)(OTb + trow * 128 + (lane & 7) * 16);
                    const size_t oi = (size_t)(crow0 + 32 * tt + trow) * R_V + h * R_DV + sl * 64 + 32 * et + 4 * (lane & 7);
                    v2u wv; wv.x = pkbf(o[0] * bflo(gfr[i].x), o[1] * bfhi(gfr[i].x)); wv.y = pkbf(o[2] * bflo(gfr[i].y), o[3] * bfhi(gfr[i].y));
                    *(GAS v2u*)(OBg + oi) = wv;
                    float ssq = (o[0] * o[0] + o[1] * o[1]) + (o[2] * o[2] + o[3] * o[3]);
                    ssq += __shfl_xor(ssq, 1); ssq += __shfl_xor(ssq, 2); ssq += __shfl_xor(ssq, 4);
                    if ((lane & 7) == 0) SSQo[(size_t)(crow0 + 32 * tt + trow) * 64 + h * 16 + sl * 2 + et] = ssq;
                }
                if (c + 1 < NCH) {
#pragma unroll
                    for (int i = 0; i < 4; ++i) {
#pragma unroll
                        for (int g = 0; g < 4; ++g) {
                            v2u w; w.x = pkbf(racc[i][4 * g], racc[i][4 * g + 1]); w.y = pkbf(racc[i][4 * g + 2], racc[i][4 * g + 3]);
                            *(LAS v2u*)(L + R3_RT + erow * 512 + 16 * ((4 * (dtb + i) + g) ^ esw) + 8 * hh) = w;
                        }
                    }
                }
#if defined(PROBE_SEC) && PROBE_SEC >= 20
                { const unsigned long long qq7 = __builtin_amdgcn_s_memtime();
                  const unsigned long long d_ = PROBE_SEC == 20 ? qq1 - qq0 : PROBE_SEC == 21 ? qq2 - qq1 : PROBE_SEC == 22 ? qq3 - qq2 : PROBE_SEC == 23 ? qq4 - qq3 : PROBE_SEC == 24 ? qq5 - qq4 : PROBE_SEC == 25 ? qq6 - qq5 : PROBE_SEC == 26 ? qq7 - qq6 : PROBE_SEC == 28 ? qq3 - qq1 : qq7 - qq0;
                  if (c >= 2 && qq7 - qq0 < qbest) { qbest = qq7 - qq0; qprobe = d_; } }
#endif
            }
#if defined(PROBE_SEC) && PROBE_SEC >= 20
            if (blockIdx.x == 0 && F.tid == PROBE_WAVE * 64) *(GAS unsigned long long*)probe_out = ((qprobe + PROBE_Q / 2) / PROBE_Q) * PROBE_Q;
#endif
            {
                const int l31 = lane0 & 31, hh = lane0 >> 5;
                gf32* sp_ = SoutP + ((size_t)(b * R_H + h) * R_DK + 4 * hh) * R_DV + sl * 64 + 32 * et + l31;
#pragma unroll
                for (int i = 0; i < 4; ++i) {
#pragma unroll
                    for (int r = 0; r < 16; ++r) sp_[(size_t)(32 * (dtb + i) + (r & 3) + 8 * (r >> 2)) * R_DV] = racc[i][r];
                }
            }
        } else {
            const int w4 = wave & 3, spl = w4 >> 1, half = w4 & 1;
            int lane = F.lane; asm volatile("" : "+v"(lane));
            const int sp = 2 * u + spl, ss = sp >> 2, sh = sp & 3, srow = MP + 4 * ss;
            const float gs4 = gC[sh * 2 + 1];
            const size_t sbase = ((size_t)(ss * R_H + sh) * R_DK) * R_DV + 256 * half + 4 * lane;
            float so[4][4], sv[4][4];
#pragma unroll
            for (int t = 0; t < 4; ++t) { const v2u vv = *(const GAS v2u*)(V + (size_t)(srow + t) * R_V + sh * R_DV + 256 * half + 4 * lane);
                sv[t][0] = bflo(vv.x); sv[t][1] = bfhi(vv.x); sv[t][2] = bflo(vv.y); sv[t][3] = bfhi(vv.y);
                so[t][0] = 0.f; so[t][1] = 0.f; so[t][2] = 0.f; so[t][3] = 0.f; }
            if (half == 0) {
#pragma unroll
                for (int t = 0; t < 4; ++t)
#pragma unroll
                    for (int i = 0; i < 4; ++i) { const int d = lane + 64 * i; const size_t gi = (size_t)(srow + t) * R_QK + sh * R_DK + d;
                        *(LAS unsigned short*)(L + R3_QK + spl * 4096 + d * 16 + t * 4) = Qh[gi]; *(LAS unsigned short*)(L + R3_QK + spl * 4096 + d * 16 + t * 4 + 2) = Kt[gi]; }
            }
            const int ppair = (u & 7) * 4 + ((u >> 3) >> 3), psl = (u >> 3) & 7, pb_ = ppair >> 2, ph = ppair & 3, prowb = pb_ * TP;
#define R3_DMA(c_) do { unsigned lb_ = Lb; asm volatile("" : "+s"(lb_)); const int cr0_ = prowb + (c_) * R_C; const unsigned kb_ = lb_ + R3_KT + ((c_) & 1) * 32768 + 16 * w4 * 512, vb_ = lb_ + R3_VT + ((c_) & 1) * 8192 + 16 * w4 * 128; \
            _Pragma("unroll") for (int i_ = 0; i_ < 8; ++i_) { const int row_ = 16 * w4 + 2 * i_ + (lane >> 5), ch_ = (lane & 31) ^ swz16(row_); \
                glds16_asm((const GAS void*)(Kt + (size_t)(cr0_ + row_) * R_QK + ph * R_DK + 8 * ch_), __builtin_amdgcn_readfirstlane(kb_ + i_ * 1024)); } \
            _Pragma("unroll") for (int i_ = 0; i_ < 2; ++i_) { const int row_ = 16 * w4 + 8 * i_ + (lane >> 3), ch_ = (lane & 7) ^ (((row_ >> 1) & 1) << 2); \
              glds16_asm((const GAS void*)(V + (size_t)(cr0_ + row_) * R_V + ph * R_DV + psl * 64 + 8 * ch_), __builtin_amdgcn_readfirstlane(vb_ + i_ * 1024)); } } while (0)
#define R3_DMAQ(c_) do { unsigned lb_ = Lb; asm volatile("" : "+s"(lb_)); const int cr0_ = prowb + (c_) * R_C; const unsigned qb_ = lb_ + R3_QT + 16 * w4 * 512; \
            _Pragma("unroll") for (int i_ = 0; i_ < 8; ++i_) { const int row_ = 16 * w4 + 2 * i_ + (lane >> 5), ch_ = (lane & 31) ^ swz16(row_); \
                glds16_asm((const GAS void*)(Qh + (size_t)(cr0_ + row_) * R_QK + ph * R_DK + 8 * ch_), __builtin_amdgcn_readfirstlane(qb_ + i_ * 1024)); } } while (0)
            R3_DMA(0); R3_DMAQ(0);
            asm volatile("s_waitcnt vmcnt(0)" ::: "memory");
            pg8::f32x4 sA[8], sB[8];
#pragma unroll
            for (int r = 0; r < 8; ++r) sA[r] = *(const gf32x4*)(S0 + sbase + (size_t)r * R_DV);
#define R3_SSTEP(c_, cur_, nxt_) do { \
                asm volatile("" : "+v"(lane)); const size_t sbase = ((size_t)(ss * R_H + sh) * R_DK) * R_DV + 256 * half + 4 * lane;      \
                  \
                asm volatile("s_waitcnt vmcnt(16) lgkmcnt(0)" ::: "memory"); __builtin_amdgcn_s_barrier(); asm volatile("" ::: "memory"); \
                if ((c_) + 1 < NCH) R3_DMA((c_) + 1); \
                __builtin_amdgcn_s_barrier(); asm volatile("" ::: "memory");                                                                \
                if ((c_) + 1 < NCH) { R3_DMAQ((c_) + 1); \
                    _Pragma("unroll") for (int r = 0; r < 8; ++r) nxt_[r] = *(const gf32x4*)(S0 + sbase + (size_t)(8 * ((c_) + 1) + r) * R_DV); } \
                asm volatile("s_waitcnt lgkmcnt(0)" ::: "memory"); __builtin_amdgcn_s_barrier(); asm volatile("" ::: "memory");            \
                _Pragma("unroll") for (int r = 0; r < 8; ++r) { \
                    const v4u qk = *(const LAS v4u*)(L + R3_QK + spl * 4096 + (8 * (c_) + r) * 16); \
                    const float q0 = bflo(qk.x), k0 = bfhi(qk.x), q1 = bflo(qk.y), k1 = bfhi(qk.y), q2 = bflo(qk.z), k2 = bfhi(qk.z), q3 = bflo(qk.w), k3 = bfhi(qk.w); \
                    pg8::f32x4 w; \
                    _Pragma("unroll") for (int cc = 0; cc < 4; ++cc) { \
                        float x = cur_[r][cc]; \
                        x += k0 * sv[0][cc]; so[0][cc] += q0 * x; \
                        x += k1 * sv[1][cc]; so[1][cc] += q1 * x; \
                        x += k2 * sv[2][cc]; so[2][cc] += q2 * x; \
                        x += k3 * sv[3][cc]; so[3][cc] += q3 * x; \
                        w[cc] = x * gs4; \
                    } \
                    *(gf32x4*)(SoutS + sbase + (size_t)(8 * (c_) + r) * R_DV) = w; \
                } } while (0)
#pragma unroll 1
            for (int c = 0; c < NCH; c += 2) { R3_SSTEP(c, sA, sB); R3_SSTEP(c + 1, sB, sA); }
#undef R3_SSTEP
#undef R3_DMA
#undef R3_DMAQ
#pragma unroll
            for (int t = 0; t < 4; ++t) {
                const size_t oi = (size_t)(srow + t) * R_V + sh * R_DV + 256 * half + 4 * lane;
                const v2u g = *(const GAS v2u*)(Gt + oi);
                v2u wv; wv.x = pkbf(so[t][0] * bflo(g.x), so[t][1] * bfhi(g.x)); wv.y = pkbf(so[t][2] * bflo(g.y), so[t][3] * bfhi(g.y));
                *(GAS v2u*)(OBg + oi) = wv;
                float ssq = (so[t][0] * so[t][0] + so[t][1] * so[t][1]) + (so[t][2] * so[t][2] + so[t][3] * so[t][3]);
                ssq += __shfl_xor(ssq, 1); ssq += __shfl_xor(ssq, 2); ssq += __shfl_xor(ssq, 4);
                if ((lane & 7) == 0) SSQo[(size_t)(srow + t) * 64 + sh * 16 + 8 * half + (lane >> 3)] = ssq;
            }
        }
        asm volatile("s_waitcnt vmcnt(0) lgkmcnt(0)" ::: "memory"); __builtin_amdgcn_s_barrier(); asm volatile("" ::: "memory");
    }
}

#ifndef PROBE_SCALE
#define PROBE_SCALE 0.05f
#endif
#ifndef PROBE_MASK
#define PROBE_MASK 0
#endif
#define PREP(type) for (int rep_ = 0; rep_ < 1 + ((PROBE_MASK >> (type)) & 1); ++rep_)
#define PSC(type, s) ((rep_ == 0) ? (s) : 0.0f)
#define PBAR(type) do { if (((PROBE_MASK >> (type)) & 1) && rep_ == 0 && use_bar) xcd_barrier(bar); } while (0)
#ifndef MK_PER_PHASE_LAUNCH
#define MK_PER_PHASE_LAUNCH 0
#endif
constexpr size_t OUT_Y = 0, OUT_RETP = (size_t)M * D, OUT_RETS = OUT_RETP + (size_t)2 * 8 * 4 * 256 * 512, OUT_HGP = OUT_RETS + (size_t)2 * 128 * 4 * 256 * 512,
                 OUT_HGS = OUT_HGP + (size_t)2 * 8 * 8 * 128 * 128, OUT_END = OUT_HGS + (size_t)2 * 128 * 8 * 128 * 128;
static_assert(OUT_END == 195559424, "output size");

template <class T> __device__ __forceinline__ GAS T* opaque(GAS T* p) { asm volatile("" : "+s"(p)); return p; }
__device__ __forceinline__ Frame local_frame(const Frame& F) {
    Frame L = F; int t = threadIdx.x; asm volatile("" : "+v"(t)); L.tid = t; L.lane = t & 63; L.wave = __builtin_amdgcn_readfirstlane(t >> 6); return L; }
struct Args { const float* in[15]; float* out; unsigned char* ws; int ph_lo, ph_hi; };

#define SSQ_PTR(ws, idx) ((gf32*)((ws) + WS_SSQ) + (size_t)(idx) * M * SSQ_SLOTS)

__device__ __forceinline__ void tail_convert(Frame& F_, GAS unsigned char* ws_, const GAS void* kargs_, int layer, int q0, int q1, int nunits) {
    const int nextra = nunits % F_.G;
    if (layer >= 4 || nextra == 0 || (int)blockIdx.x < nextra) return;
    Frame F = local_frame(F_); GAS unsigned char* ws = opaque(ws_);
    const GAS Args* ka = (const GAS Args*)opaque((const GAS unsigned char*)kargs_);
#define KIN(i) ((const gf32*)ka->in[i])
    PrologueArgs A{KIN(0), KIN(1), KIN(4), KIN(5), KIN(6), KIN(7), KIN(8), KIN(9), KIN(10), KIN(11), KIN(12), KIN(13), ws};
#undef KIN
    convert_layer_weights(F, A, layer, q0, q1, ((int)blockIdx.x - nextra) * NWAVES + F.wave, (F.G - nextra) * NWAVES);
}
__device__ __forceinline__ void ffn_up(Frame& F, GAS unsigned char* ws_, int idx, int ssq_idx) {
    GAS unsigned char* ws = opaque(ws_);
    pg8::Gemm g{(const bf16*)(ws + WS_XB), (const bf16*)(ws + WS_W + idx * W_FFN_STRIDE), M, NUP, D};
    pg8::StaticOrder S; S.init(M, NUP, F.G, (int)blockIdx.x);
    EpiUp E{(gbf16*)(ws + WS_HID), stage_row_rstd(F.lds, S, SSQ_PTR(ws, ssq_idx), (int)threadIdx.x)};
    pg8::gemm_phase<EpiUp, pg8::StaticOrder, true, true>(F.lds + RING_OFF, g, S, E);
}
__device__ __forceinline__ void res_gemm(Frame& F, GAS unsigned char* ws_, size_t a_off, size_t w_off, int K, int ssq_idx, float scale) {
    GAS unsigned char* ws = opaque(ws_);
    pg8::Gemm g{(const bf16*)(ws + a_off), (const bf16*)(ws + w_off), MP, D, K};
    pg8::StaticOrder S; S.init(MP, D, F.G, (int)blockIdx.x);
    EpiRes E{(gbf16*)(ws + WS_XB), SSQ_PTR(ws, ssq_idx), scale};
    pg8::gemm_phase<EpiRes, pg8::StaticOrder, true, true>(F.lds + RING_OFF, g, S, E);
    Frame FL = local_frame(F);
    mini_res_gemm(FL, (const gbf16*)(ws + a_off), (const gbf16*)(ws + w_off), K, (gbf16*)(ws + WS_XB), SSQ_PTR(ws, ssq_idx), scale);
}
__device__ __forceinline__ void res_gemm_ks(Frame& F, GAS unsigned char* ws_, size_t a_off, size_t w_off, int K, int ssq_idx, float scale) {
    GAS unsigned char* ws = opaque(ws_);
    pg8::Gemm g{(const bf16*)(ws + a_off), (const bf16*)(ws + w_off), MP, D, K};
    pg8::StaticOrder S; S.init(MP, D, F.G, (int)blockIdx.x);
    LAS unsigned char* lfac = F.lds + 131072;
    { int t_ = F.tid; asm volatile("" : "+v"(t_)); pg8::Unit u0; if (S.next(0, u0) && t_ < 256) { const gf32* sq = (const gf32*)(ws + WS_SSQO); const int row = u0.pm * 256 + t_;
        const float r0 = ret_head_rstd(sq, row, 0), r1 = ret_head_rstd(sq, row, 1), r2 = ret_head_rstd(sq, row, 2), r3 = ret_head_rstd(sq, row, 3);
        *(LAS f32x4*)(lfac + t_ * 16) = (f32x4){r0 / r1, r1 / r2, r2 / r3, r3}; } }
    LDS_WAIT(); __syncthreads();
    EpiResKS E{{(gbf16*)(ws + WS_XB), SSQ_PTR(ws, ssq_idx), scale}, lfac};
    pg8::gemm_phase<EpiResKS, pg8::StaticOrder, true, true>(F.lds + RING_OFF, g, S, E);
    Frame FL = local_frame(F);
    mini_res_gemm(FL, (const gbf16*)(ws + a_off), (const gbf16*)(ws + w_off), K, (gbf16*)(ws + WS_XB), SSQ_PTR(ws, ssq_idx), scale, (const gf32*)(ws + WS_SSQO));
}
__device__ __forceinline__ void ret_in_gemm(Frame& F, GAS unsigned char* ws_, int j, int ssq_idx) {
    GAS unsigned char* ws = opaque(ws_); const gf32* tab2 = (const gf32*)(ws + WS_TAB2);
    pg8::Gemm g{(const bf16*)(ws + WS_XB), (const bf16*)(ws + WS_W + W_RET_BASE + j * W_RET_STRIDE), M, R_NIN, D};
    pg8::StaticOrder S; S.init(M, R_NIN, F.G, (int)blockIdx.x);
    EpiRetIn E{(gbf16*)(ws + WS_QB), (gbf16*)(ws + WS_KB), (gbf16*)(ws + WS_VB), (gbf16*)(ws + WS_GB), stage_row_rstd(F.lds, S, SSQ_PTR(ws, ssq_idx), (int)threadIdx.x), (const gf32*)(ws + WS_ROPE), tab2, tab2 + 512};
    pg8::gemm_phase<EpiRetIn, pg8::StaticOrder, true, true>(F.lds + RING_OFF, g, S, E);
}
__device__ __forceinline__ void hg_in_gemm(Frame& F, GAS unsigned char* ws_, int j, int ssq_idx) {
    GAS unsigned char* ws = opaque(ws_); const gf32* tab2 = (const gf32*)(ws + WS_TAB2);
    pg8::Gemm g{(const bf16*)(ws + WS_XB), (const bf16*)(ws + WS_W + W_HG_BASE + j * W_HG_STRIDE), M, G_NIN, D};
    pg8::StaticOrder S; S.init(M, G_NIN, F.G, (int)blockIdx.x);
    EpiHgIn E{(gbf16*)(ws + WS_QB), (gbf16*)(ws + WS_KB), (gbf16*)(ws + WS_VB), (gbf16*)(ws + WS_GB), (gf32*)(ws + WS_EB), stage_row_rstd(F.lds, S, SSQ_PTR(ws, ssq_idx), (int)threadIdx.x), tab2 + 2048 + j * 1024};
    pg8::gemm_phase<EpiHgIn, pg8::StaticOrder, true, true>(F.lds + RING_OFF, g, S, E);
}
__device__ __forceinline__ void ret_rec(Frame& F_, GAS unsigned char* ws_, const gf32* st_, gf32* out_, int j) {
    Frame F = local_frame(F_); GAS unsigned char* ws = opaque(ws_); const gf32* st = opaque(st_); gf32* out = opaque(out_);
    ret_rec3(F, (const gbf16*)(ws + WS_QB), (const gbf16*)(ws + WS_KB), (const gbf16*)(ws + WS_VB), (const gf32*)(ws + WS_TAB2) + 1024, (const gbf16*)(ws + WS_GB), (gbf16*)(ws + WS_OB), (gf32*)(ws + WS_SSQO),
             st + (size_t)j * NSEQ_S * R_H * R_DK * R_DV, out + OUT_RETP + (size_t)j * NSEQ_P * R_H * R_DK * R_DV, out + OUT_RETS + (size_t)j * NSEQ_S * R_H * R_DK * R_DV, (GAS void*)(ws + WS_CTL + 32768));
}
__device__ __forceinline__ void hg_rec(Frame& F_, GAS unsigned char* ws_, const gf32* st_, gf32* out_, int j) {
    Frame F = local_frame(F_); GAS unsigned char* ws = opaque(ws_); const gf32* st = opaque(st_); gf32* out = opaque(out_);
    PREP(12)
    hg_fast(F, (const gbf16*)(ws + WS_QB), (const gbf16*)(ws + WS_KB), (const gbf16*)(ws + WS_VB), (const gf32*)(ws + WS_EB), (gbf16*)(ws + WS_OF),
            out + OUT_HGP + (size_t)j * NSEQ_P * G_H * G_DK * G_DV, (GAS void*)(ws + WS_CTL + 32768));
    asm volatile("s_waitcnt vmcnt(0) lgkmcnt(0)" ::: "memory"); __syncthreads();
    rec_naive<G_DK, G_DV, G_H, G_C>(F, (const gbf16*)(ws + WS_QB), (const gbf16*)(ws + WS_KB), (const gbf16*)(ws + WS_VB), (const gf32*)(ws + WS_EB), nullptr,
                                    st + (size_t)j * NSEQ_S * G_H * G_DK * G_DV, (gbf16*)(ws + WS_OF),
                                    out + OUT_HGP + (size_t)j * NSEQ_P * G_H * G_DK * G_DV, out + OUT_HGS + (size_t)j * NSEQ_S * G_H * G_DK * G_DV, NSEQ_P * G_H * (G_DV / 64),
                                    F.G > 2 * NSEQ_P * G_H ? NSEQ_P * G_H : 0);
}

__global__ void __launch_bounds__(NWAVES * 64, 2) mk_fwd(Args args) {
    extern __shared__ __attribute__((aligned(16))) unsigned char lds[];
    Frame F;
    F.lds = (LAS unsigned char*)lds;
    F.MISC = (volatile LAS unsigned*)(F.lds + MISC_OFF);
    F.tid = threadIdx.x; F.lane = F.tid & 63; F.wave = __builtin_amdgcn_readfirstlane(F.tid >> 6);
    F.G = gridDim.x;
    GAS unsigned char* ws = (GAS unsigned char*)args.ws;
    const GAS void* kargs = (const GAS void*)__builtin_amdgcn_kernarg_segment_ptr();
    F.ctl = (gu32*)(ws + WS_CTL);
    for (int u = F.tid; u < (LDS_BYTES - LDSCTL_OFF) / 4; u += NWAVES * 64) ((LAS unsigned*)(F.lds + LDSCTL_OFF))[u] = 0u;
    __syncthreads();
    int lo = args.ph_lo, hi = args.ph_hi;
    const bool use_bar = (hi - lo) > 1;
    XcdBarrier bar; bar.bar = (unsigned*)(F.ctl + CW_BAR); bar.x = 0; bar.st = nullptr;
    if (use_bar) bar = xcd_barrier_post((unsigned*)(F.ctl + CW_BAR), F.MISC + 8);
#define IN(k) (lo <= (k) && (k) < hi)
#define SEAM(k) do { if (IN(k) && IN((k) + 1)) xcd_barrier(bar); } while (0)

    if (IN(0)) {
        Frame FL = local_frame(F);
        #define GIN(i) ((const gf32*)args.in[i])
        PrologueArgs A{GIN(0), GIN(1), GIN(4), GIN(5), GIN(6), GIN(7), GIN(8), GIN(9), GIN(10), GIN(11), GIN(12), GIN(13), ws};
        PREP(0) { p0_prologue(FL, A); PBAR(0); }
    }
    SEAM(0);

    for (int L = 0; L < 4; ++L) {
        const int pb = 1 + 8 * L, j = L >> 1;
        asm volatile("" : "+s"(lo), "+s"(hi));
        if (IN(pb + 0)) { PREP(1) { ffn_up(F, ws, 2 * L, 3 * L); PBAR(1); } tail_convert(F, ws, kargs, L + 1, 0, 1, (M / 256) * (NUP / 256)); }
        SEAM(pb + 0);
        if (IN(pb + 1)) PREP(2) { res_gemm(F, ws, WS_HID, WS_W + (2 * L) * W_FFN_STRIDE + W_DOWN_OFF, FF, 3 * L + 1, PSC(2, 0.5f)); PBAR(2); }
        SEAM(pb + 1);
        if ((L & 1) == 0) {
            if (IN(pb + 2)) { PREP(3) { ret_in_gemm(F, ws, j, 3 * L + 1); PBAR(3); } tail_convert(F, ws, kargs, L + 1, 1, 3, (M / 256) * (R_NIN / 256)); }
            SEAM(pb + 2);
            if (IN(pb + 3)) PREP(4) { ret_rec(F, ws, GIN(2), (gf32*)args.out, j); PBAR(4); }
            SEAM(pb + 3);
            if (IN(pb + 5)) PREP(6) { res_gemm_ks(F, ws, WS_OB, WS_W + W_RET_BASE + j * W_RET_STRIDE + W_ROUT_OFF, R_V, 3 * L + 2, PSC(6, 1.0f)); PBAR(6); }
            SEAM(pb + 5);
        } else {
            if (IN(pb + 2)) { PREP(7) { hg_in_gemm(F, ws, j, 3 * L + 1); PBAR(7); } tail_convert(F, ws, kargs, L + 1, 1, 3, (M / 256) * (G_NIN / 256)); }
            SEAM(pb + 2);
            if (IN(pb + 3)) PREP(8) { hg_rec(F, ws, GIN(3), (gf32*)args.out, j); PBAR(8); }
            SEAM(pb + 3);
            if (IN(pb + 4)) PREP(9) { PBAR(9); GAS unsigned char* w = opaque(ws); Frame FL = local_frame(F); headnorm_phase<G_DV>(FL, (const gbf16*)(w + WS_OF), (const gbf16*)(w + WS_GB), (gbf16*)(w + WS_OB), M * D / 512); }
            SEAM(pb + 4);
            if (IN(pb + 5)) PREP(10) { res_gemm(F, ws, WS_OB, WS_W + W_HG_BASE + j * W_HG_STRIDE + W_HOUT_OFF, D, 3 * L + 2, PSC(10, 1.0f)); PBAR(10); }
            SEAM(pb + 5);
        }
        if (IN(pb + 6)) { PREP(1) { ffn_up(F, ws, 2 * L + 1, 3 * L + 2); PBAR(1); } tail_convert(F, ws, kargs, L + 1, 3, 4, (M / 256) * (NUP / 256)); }
        SEAM(pb + 6);
        if (IN(pb + 7)) PREP(2) { res_gemm(F, ws, WS_HID, WS_W + (2 * L + 1) * W_FFN_STRIDE + W_DOWN_OFF, FF, 3 * L + 3, PSC(2, 0.5f)); PBAR(2); }
        SEAM(pb + 7);
    }
    if (IN(33)) { GAS unsigned char* w = opaque(ws); Frame FL = local_frame(F); final_phase(FL, (const gbf16*)(w + WS_XB), SSQ_PTR(w, 12), GIN(14), (gf32*)args.out + OUT_Y
#ifdef PROBE_SEC
            , 1.0f + PROBE_SCALE * (float)(*(const GAS unsigned long long*)(w + WS_CTL + 32768)) * 1e-3f
#else
            , 1.0f
#endif
            ); }
#undef IN
#undef SEAM
}

extern "C" void kernel_launch(void* const* d_in, const int* in_sizes, int n_in, void* d_out, int out_size, void* d_ws, size_t ws_size, hipStream_t stream) {
    static int grid = 0;
    if (grid == 0) {
        if (n_in != 15 || (size_t)out_size != OUT_END || ws_size < WS_END) { fprintf(stderr, "kernel_launch: unexpected shapes (n_in %d out %d ws %zu)\n", n_in, out_size, ws_size); grid = -1; return; }
        int dev = 0, cus = 0, per_cu = 0;
        if (hipGetDevice(&dev) != hipSuccess || hipDeviceGetAttribute(&cus, hipDeviceAttributeMultiprocessorCount, dev) != hipSuccess) { grid = -1; return; }
        if (hipFuncSetAttribute((const void*)mk_fwd, hipFuncAttributeMaxDynamicSharedMemorySize, LDS_BYTES) != hipSuccess) { fprintf(stderr, "kernel_launch: hipFuncSetAttribute failed\n"); grid = -1; return; }
        if (hipOccupancyMaxActiveBlocksPerMultiprocessor(&per_cu, (const void*)mk_fwd, NWAVES * 64, LDS_BYTES) != hipSuccess || per_cu < 1) { fprintf(stderr, "kernel_launch: occupancy query says %d\n", per_cu); per_cu = 1; }
        (void)hipGetLastError();
        grid = cus;
    }
    if (grid < 0) return;
    (void)hipMemsetAsync((char*)d_ws + WS_CTL, 0, CTL_ZERO_BYTES, stream);
    Args a{};
    for (int i = 0; i < 15; ++i) a.in[i] = (const float*)d_in[i];
    a.out = (float*)d_out; a.ws = (unsigned char*)d_ws;
#if MK_PER_PHASE_LAUNCH
    for (int p = 0; p < NPHASE; ++p) { a.ph_lo = p; a.ph_hi = p + 1; hipLaunchKernelGGL(mk_fwd, dim3(grid), dim3(NWAVES * 64), LDS_BYTES, stream, a); }
#else
    a.ph_lo = 0; a.ph_hi = NPHASE;
    hipLaunchKernelGGL(mk_fwd, dim3(grid), dim3(NWAVES * 64), LDS_BYTES, stream, a);
#endif
}
```
